# Optimizing an MI355X kernel written in HIP

```python
import math
import jax
import jax.numpy as jnp
from jax import lax
import numpy as np

D_MODEL = 2048
BATCH = 4
SEQ = 4096
DEPTH = 1

EPS = 1e-6
NEG_INF = -1e30
MLA_HEADS = 8
MLA_NOPE = 128
MLA_ROPE = 64
MLA_V = 128
MLA_Q_LORA = 512
MLA_KV_LORA = 512
ROPE_THETA = 10000.0
ATTN_Q_BLOCK = 128
MOBA_HEADS = 8
MOBA_HEAD_DIM = 128
MOBA_BLOCK = 256
MOBA_TOPK = 3
MOBA_Q_CHUNK = 64
REL_BUCKETS = 32
REL_MAX_DIST = 128
N_EXPERTS = 32
TOP_K = 4
D_EXPERT = D_MODEL
SWIGLU_LIMIT = 7.0
SWIGLU_ALPHA = 1.702
EXPERT_ROW_BLOCK = 256
PLE_DIM = 256
IN_SIZES = (MLA_Q_LORA, MLA_KV_LORA, MLA_ROPE,
            MOBA_HEADS * MOBA_HEAD_DIM, MOBA_HEADS * MOBA_HEAD_DIM, MOBA_HEADS * MOBA_HEAD_DIM,
            D_MODEL, D_MODEL)
IN_COLS = MLA_Q_LORA + MLA_KV_LORA + MLA_ROPE + 3 * MOBA_HEADS * MOBA_HEAD_DIM + 2 * D_MODEL

kernel_name = 'hybrid_mla_moba_moe_ple_block'


def rms_norm(x, g):
    xf = x.astype(jnp.float32)
    y = xf * lax.rsqrt(jnp.mean(xf * xf, axis=-1, keepdims=True) + EPS)
    return (y * g.astype(jnp.float32)).astype(x.dtype)


def split_cols(z, sizes):
    parts, start = [], 0
    for s in sizes:
        parts.append(z[..., start:start + s])
        start += s
    return parts


def rope_tables(seq):
    inv = 1.0 / (ROPE_THETA ** (jnp.arange(0, MLA_ROPE, 2, dtype=jnp.float32) / MLA_ROPE))
    ang = jnp.arange(seq, dtype=jnp.float32)[:, None] * inv[None, :]
    return jnp.cos(ang), jnp.sin(ang)


def apply_rope(x, cos, sin):
    half = x.shape[-1] // 2
    x1, x2 = x[..., :half], x[..., half:]
    c, s = cos.astype(x.dtype), sin.astype(x.dtype)
    return jnp.concatenate([x1 * c - x2 * s, x1 * s + x2 * c], axis=-1)


def t5_bucket(dist):
    n = jnp.maximum(dist, 0)
    max_exact = REL_BUCKETS // 2
    large = max_exact + (jnp.log(jnp.maximum(n, 1).astype(jnp.float32) / max_exact)
                         / math.log(REL_MAX_DIST / max_exact)
                         * (REL_BUCKETS - max_exact)).astype(jnp.int32)
    large = jnp.minimum(large, REL_BUCKETS - 1)
    return jnp.where(n < max_exact, n, large)


def causal_block_attention(q, k, v, scale):
    B, S, H, Dk = q.shape
    nq = S // ATTN_Q_BLOCK
    qb = jnp.moveaxis(q.reshape(B, nq, ATTN_Q_BLOCK, H, Dk), 1, 0)
    kpos = jnp.arange(S)

    def one_block(args):
        qi, i = args
        s = jnp.einsum('bqhd,bkhd->bhqk', qi, k).astype(jnp.float32) * scale
        qpos = i * ATTN_Q_BLOCK + jnp.arange(ATTN_Q_BLOCK)
        s = jnp.where(kpos[None, :] <= qpos[:, None], s, NEG_INF)
        pr = jax.nn.softmax(s, axis=-1).astype(v.dtype)
        return jnp.einsum('bhqk,bkhd->bqhd', pr, v)

    out = lax.map(one_block, (qb, jnp.arange(nq)))
    return jnp.moveaxis(out, 0, 1).reshape(B, S, H, v.shape[-1])


def mla_attention(q_lat, kv_lat, k_rope, q_lat_norm, kv_lat_norm, w_uq, w_ukv):
    B, S, _ = q_lat.shape
    q = (rms_norm(q_lat, q_lat_norm) @ w_uq).reshape(B, S, MLA_HEADS, MLA_NOPE + MLA_ROPE)
    kv = (rms_norm(kv_lat, kv_lat_norm) @ w_ukv).reshape(B, S, MLA_HEADS, MLA_NOPE + MLA_V)
    cos, sin = rope_tables(S)
    q_rope = apply_rope(q[..., MLA_NOPE:], cos[:, None, :], sin[:, None, :])
    k_rope = apply_rope(k_rope, cos, sin)
    q = jnp.concatenate([q[..., :MLA_NOPE], q_rope], axis=-1)
    k = jnp.concatenate([kv[..., :MLA_NOPE],
                         jnp.broadcast_to(k_rope[:, :, None, :], (B, S, MLA_HEADS, MLA_ROPE))], axis=-1)
    v = kv[..., MLA_NOPE:]
    out = causal_block_attention(q, k, v, (MLA_NOPE + MLA_ROPE) ** -0.5)
    return out.reshape(B, S, MLA_HEADS * MLA_V)


def moba_attention(q, k, v, rel_bias):
    B, S, H, D = q.shape
    Sp = ((S + MOBA_BLOCK - 1) // MOBA_BLOCK) * MOBA_BLOCK
    pad = ((0, 0), (0, Sp - S), (0, 0), (0, 0))
    q, k, v = jnp.pad(q, pad), jnp.pad(k, pad), jnp.pad(v, pad)
    nb = Sp // MOBA_BLOCK
    nc = Sp // MOBA_Q_CHUNK
    n_sel = min(MOBA_TOPK, nb)
    qh = q.transpose(0, 2, 1, 3)
    kbh = k.transpose(0, 2, 1, 3).reshape(B, H, nb, MOBA_BLOCK, D)
    vbh = v.transpose(0, 2, 1, 3).reshape(B, H, nb, MOBA_BLOCK, D)
    k_mean = jnp.mean(kbh.astype(jnp.float32), axis=3)
    gate = jnp.einsum('bhsd,bhnd->bhsn', qh.astype(jnp.float32), k_mean)
    q_blk = jnp.arange(Sp) // MOBA_BLOCK
    past = jnp.arange(nb)[None, :] < q_blk[:, None]
    gate = jnp.where(past, gate, NEG_INF)
    _, sel = lax.top_k(gate, n_sel)
    sel_valid = sel < q_blk[:, None]

    def to_chunks(a):
        return jnp.moveaxis(a.reshape((B, H, nc, MOBA_Q_CHUNK) + a.shape[3:]), 2, 0)

    b_ix = jnp.arange(B)[:, None, None, None]
    h_ix = jnp.arange(H)[None, :, None, None]
    h_ix5 = jnp.arange(H)[None, :, None, None, None]
    offs = jnp.arange(MOBA_BLOCK)
    table_h = rel_bias.T
    scale = D ** -0.5

    def one_chunk(args):
        qc, selc, validc, c = args
        qpos = c * MOBA_Q_CHUNK + jnp.arange(MOBA_Q_CHUNK)
        gk = kbh[b_ix, h_ix, selc]
        gv = vbh[b_ix, h_ix, selc]
        s_sel = jnp.einsum('bhqd,bhqtkd->bhqtk', qc, gk).astype(jnp.float32) * scale
        kpos_sel = selc[..., None] * MOBA_BLOCK + offs
        s_sel = s_sel + table_h[h_ix5, t5_bucket(qpos[:, None, None] - kpos_sel)].astype(jnp.float32)
        s_sel = jnp.where(validc[..., None], s_sel, NEG_INF).reshape(B, H, MOBA_Q_CHUNK, n_sel * MOBA_BLOCK)
        j = (c * MOBA_Q_CHUNK) // MOBA_BLOCK
        ko = lax.dynamic_index_in_dim(kbh, j, axis=2, keepdims=False)
        vo = lax.dynamic_index_in_dim(vbh, j, axis=2, keepdims=False)
        dist_own = qpos[:, None] - (j * MOBA_BLOCK + offs)[None, :]
        s_own = jnp.einsum('bhqd,bhkd->bhqk', qc, ko).astype(jnp.float32) * scale
        s_own = s_own + table_h[:, t5_bucket(dist_own)].astype(jnp.float32)
        s_own = jnp.where(dist_own >= 0, s_own, NEG_INF)
        pr = jax.nn.softmax(jnp.concatenate([s_sel, s_own], axis=-1), axis=-1).astype(v.dtype)
        p_sel = pr[..., :n_sel * MOBA_BLOCK].reshape(B, H, MOBA_Q_CHUNK, n_sel, MOBA_BLOCK)
        p_own = pr[..., n_sel * MOBA_BLOCK:]
        return (jnp.einsum('bhqtk,bhqtkd->bhqd', p_sel, gv)
                + jnp.einsum('bhqk,bhkd->bhqd', p_own, vo))

    outs = lax.map(one_chunk, (to_chunks(qh), to_chunks(sel), to_chunks(sel_valid), jnp.arange(nc)))
    out = jnp.moveaxis(outs, 0, 2).reshape(B, H, Sp, D).transpose(0, 2, 1, 3)
    return out[:, :S]


def clamped_swiglu(g, u):
    g = jnp.minimum(g, SWIGLU_LIMIT)
    u = jnp.clip(u, -SWIGLU_LIMIT, SWIGLU_LIMIT)
    return g * jax.nn.sigmoid(SWIGLU_ALPHA * g) * (u + 1.0)


def moe_ffn(xn, w_router, b_router, w_gate, b_gate, w_up, b_up, w_down, b_down):
    B, S, D = xn.shape
    T = B * S
    xt = xn.reshape(T, D)
    logits = (xt @ w_router + b_router).astype(jnp.float32)
    top_val, top_idx = lax.top_k(logits, TOP_K)
    weights = jax.nn.softmax(top_val, axis=-1)
    A = T * TOP_K
    flat_e = top_idx.reshape(A)
    order = jnp.argsort(flat_e)
    sorted_e = flat_e[order]
    counts = jnp.bincount(flat_e, length=N_EXPERTS)
    padded = (counts + EXPERT_ROW_BLOCK - 1) // EXPERT_ROW_BLOCK * EXPERT_ROW_BLOCK
    start = jnp.cumsum(counts) - counts
    pend = jnp.cumsum(padded)
    pstart = pend - padded
    dest = pstart[sorted_e] + jnp.arange(A) - start[sorted_e]
    P = A + N_EXPERTS * EXPERT_ROW_BLOCK
    n_blocks = P // EXPERT_ROW_BLOCK
    row_token = jnp.full((P,), T, jnp.int32).at[dest].set((order // TOP_K).astype(jnp.int32))
    row_weight = jnp.zeros((P,), jnp.float32).at[dest].set(weights.reshape(A)[order])
    block_start = jnp.arange(n_blocks) * EXPERT_ROW_BLOCK
    block_expert = jnp.minimum(jnp.searchsorted(pend, block_start, side='right'), N_EXPERTS - 1)
    x_pad = jnp.concatenate([xt, jnp.zeros((1, D), xt.dtype)], axis=0)

    def expert_block(args):
        rows, e, wts = args
        xb = x_pad[rows]
        g = xb @ w_gate[e] + b_gate[e]
        u = xb @ w_up[e] + b_up[e]
        y = clamped_swiglu(g, u) @ w_down[e] + b_down[e]
        return y * wts[:, None].astype(y.dtype)

    y = lax.map(expert_block, (row_token.reshape(n_blocks, EXPERT_ROW_BLOCK), block_expert,
                               row_weight.reshape(n_blocks, EXPERT_ROW_BLOCK)))
    out = jnp.zeros((T + 1, D), y.dtype).at[row_token].add(y.reshape(P, D))
    return out[:T].reshape(B, S, D)


def setup_inputs(seed: int = 0) -> dict:
    key = jax.random.key(seed)
    ks = jax.random.split(key, 32)
    f32 = jnp.float32
    L = DEPTH

    def nrm(k, shape, scale):
        return jax.random.normal(k, shape, f32) * scale

    def gain(k, shape):
        return 1.0 + 0.05 * jax.random.normal(k, shape, f32)

    mw = MOBA_HEADS * MOBA_HEAD_DIM
    return {
        'x': nrm(ks[0], (BATCH, SEQ, D_MODEL), 1.0),
        'p': nrm(ks[1], (DEPTH, BATCH, SEQ, PLE_DIM), 1.0),
        'attn_norm': gain(ks[2], (L, D_MODEL)),
        'w_in': nrm(ks[3], (L, D_MODEL, IN_COLS), D_MODEL ** -0.5),
        'q_lat_norm': gain(ks[4], (L, MLA_Q_LORA)),
        'kv_lat_norm': gain(ks[5], (L, MLA_KV_LORA)),
        'w_uq': nrm(ks[6], (L, MLA_Q_LORA, MLA_HEADS * (MLA_NOPE + MLA_ROPE)), MLA_Q_LORA ** -0.5),
        'w_ukv': nrm(ks[7], (L, MLA_KV_LORA, MLA_HEADS * (MLA_NOPE + MLA_V)), MLA_KV_LORA ** -0.5),
        'w_o_mla': nrm(ks[8], (L, MLA_HEADS * MLA_V, D_MODEL), (MLA_HEADS * MLA_V) ** -0.5),
        'w_o_moba': nrm(ks[9], (L, mw, D_MODEL), mw ** -0.5),
        'w_out': nrm(ks[10], (L, D_MODEL, D_MODEL), D_MODEL ** -0.5),
        'rel_bias': nrm(ks[11], (REL_BUCKETS, MOBA_HEADS), 0.2),
        'moe_norm': gain(ks[12], (L, D_MODEL)),
        'w_router': nrm(ks[13], (L, D_MODEL, N_EXPERTS), D_MODEL ** -0.5),
        'b_router': nrm(ks[14], (L, N_EXPERTS), 0.01),
        'w_gate': nrm(ks[15], (L, N_EXPERTS, D_MODEL, D_EXPERT), D_MODEL ** -0.5),
        'b_gate': nrm(ks[16], (L, N_EXPERTS, D_EXPERT), 0.02),
        'w_up': nrm(ks[17], (L, N_EXPERTS, D_MODEL, D_EXPERT), D_MODEL ** -0.5),
        'b_up': nrm(ks[18], (L, N_EXPERTS, D_EXPERT), 0.02),
        'w_down': nrm(ks[19], (L, N_EXPERTS, D_EXPERT, D_MODEL), D_EXPERT ** -0.5),
        'b_down': nrm(ks[20], (L, N_EXPERTS, D_MODEL), 0.02),
        'ple_norm': gain(ks[21], (L, D_MODEL)),
        'w_ple_gate': nrm(ks[22], (L, D_MODEL, D_MODEL), D_MODEL ** -0.5),
        'w_ple': nrm(ks[23], (L, PLE_DIM, D_MODEL), PLE_DIM ** -0.5),
        'final_norm': gain(ks[24], (D_MODEL,)),
    }


def reference(x, p, attn_norm, w_in, q_lat_norm, kv_lat_norm, w_uq, w_ukv, w_o_mla, w_o_moba,
              w_out, rel_bias, moe_norm, w_router, b_router, w_gate, b_gate, w_up, b_up,
              w_down, b_down, ple_norm, w_ple_gate, w_ple, final_norm):
    B, S, _ = x.shape
    h = x
    for i in range(DEPTH):
        xn = rms_norm(h, attn_norm[i])
        z = xn @ w_in[i]
        q_lat, kv_lat, k_rope, q_b, k_b, v_b, g_a, g_b = split_cols(z, IN_SIZES)
        y_a = mla_attention(q_lat, kv_lat, k_rope, q_lat_norm[i], kv_lat_norm[i], w_uq[i], w_ukv[i])
        hs = (B, S, MOBA_HEADS, MOBA_HEAD_DIM)
        y_b = moba_attention(q_b.reshape(hs), k_b.reshape(hs), v_b.reshape(hs), rel_bias)
        y_b = y_b.reshape(B, S, MOBA_HEADS * MOBA_HEAD_DIM)
        merged = (jax.nn.sigmoid(g_a) * (y_a @ w_o_mla[i])
                  + jax.nn.sigmoid(g_b) * (y_b @ w_o_moba[i]))
        h = h + merged @ w_out[i]
        h = h + moe_ffn(rms_norm(h, moe_norm[i]), w_router[i], b_router[i], w_gate[i], b_gate[i],
                        w_up[i], b_up[i], w_down[i], b_down[i])
        ple_gate = jax.nn.sigmoid(rms_norm(h, ple_norm[i]) @ w_ple_gate[i])
        h = h + (p[i] @ w_ple[i]) * ple_gate
    return rms_norm(h, final_norm)
```

```cpp
#include <hip/hip_runtime.h>
#include <cstdio>
#include <cstdint>

#ifndef MK_N_LAUNCHES
#define MK_N_LAUNCHES 1
#endif

#define GAS __attribute__((address_space(1)))
#define LAS __attribute__((address_space(3)))
typedef unsigned short bf16_t;
typedef short bf16x8 __attribute__((ext_vector_type(8)));
typedef short s16x4 __attribute__((ext_vector_type(4)));
typedef float f32x2 __attribute__((ext_vector_type(2)));
typedef float f32x4 __attribute__((ext_vector_type(4)));
typedef float f32x16 __attribute__((ext_vector_type(16)));
typedef unsigned u32x2 __attribute__((ext_vector_type(2)));
typedef unsigned u32x4 __attribute__((ext_vector_type(4)));

constexpr int DM = 2048, NBATCH = 4, SEQ = 4096, T = NBATCH * SEQ;
constexpr int NZ = 8448;
constexpr int ZC_QL = 0, ZC_KVL = 512, ZC_QB = 1024, ZC_KB = 2048, ZC_VB = 3072, ZC_GA = 4096, ZC_GB = 6144, ZC_KR = 8192;
constexpr int NE = 32, TOPK = 4, NA = T * TOPK;
constexpr int PMAX = NA + NE * 256;
constexpr int MAXTILES = PMAX / 256;
constexpr float EPS = 1e-6f;
constexpr int NPHASE = 16;

constexpr size_t MiB = 1u << 20;
constexpr size_t WS_CTL = 0, CTL_ZERO_BYTES = 1 * MiB;
constexpr size_t WS_ROPE = 1 * MiB;
constexpr size_t WS_KM = 2 * MiB;
constexpr size_t WS_TILE = 3 * MiB;
constexpr size_t WS_AE = 4 * MiB, WS_AP = 5 * MiB, WS_AW = 6 * MiB, WS_DEST = 7 * MiB;
constexpr size_t WS_PB = 8 * MiB;
constexpr size_t WS_KR = 16 * MiB;
constexpr size_t WS_WIN = 18 * MiB;
constexpr size_t WS_WUQ = 51 * MiB, WS_WUKV = 53 * MiB, WS_WOA = 55 * MiB, WS_WOB = 59 * MiB, WS_WOUT = 63 * MiB, WS_WPG = 71 * MiB, WS_WPLE = 79 * MiB;
constexpr size_t WS_WGU = 80 * MiB;
constexpr size_t WS_WDN = 592 * MiB;
constexpr size_t WS_H1 = 848 * MiB;
constexpr size_t WS_XN = 976 * MiB;
constexpr size_t WS_R4 = 1040 * MiB;
constexpr size_t WS_R1 = 1168 * MiB;
constexpr size_t WS_R2 = 1456 * MiB;
constexpr size_t WS_QM = WS_R2, WS_KV = WS_R2 + 48 * MiB, WS_YA = WS_R2 + 112 * MiB, WS_YB = WS_R2 + 144 * MiB, WS_M1 = WS_R2 + 176 * MiB;
constexpr size_t WS_END = 1744 * MiB;
constexpr int CW_TMO = 0;
constexpr int CW_BAR = 4096;
constexpr int CW_CNT = 16384;

constexpr int RING_BYTES = 131072;
constexpr int LDSCTL_OFF = RING_BYTES, MISC_OFF = LDSCTL_OFF + 320;
constexpr int LDS_BYTES = 147456;

#define LDS_WAIT() asm volatile("s_waitcnt lgkmcnt(0)" ::: "memory")
#define VM_WAIT() asm volatile("s_waitcnt vmcnt(0)" ::: "memory")
#define RLX_AGENT __ATOMIC_RELAXED, __HIP_MEMORY_SCOPE_AGENT

__device__ __forceinline__ unsigned cvtpk(float lo, float hi) { unsigned r; asm volatile("v_cvt_pk_bf16_f32 %0, %1, %2" : "=v"(r) : "v"(lo), "v"(hi)); return r; }
__device__ __forceinline__ float bf2f(unsigned short b) { return __uint_as_float(((unsigned)b) << 16); }
__device__ __forceinline__ float bflo(unsigned w) { return __uint_as_float(w << 16); }
__device__ __forceinline__ float bfhi(unsigned w) { return __uint_as_float(w & 0xffff0000u); }
__device__ __forceinline__ float sigmoidf_(float x) { return __builtin_amdgcn_rcpf(1.0f + __expf(-x)); }
__device__ __forceinline__ float wave_sum(float v) {
#pragma unroll
    for (int o = 1; o < 64; o <<= 1) v += __shfl_xor(v, o);
    return v;
}
__device__ __forceinline__ int ld_agent_i(const int* p) { return __hip_atomic_load(p, RLX_AGENT); }

#define XB_TMO      128
#define XB_XCNT(j)  (256  + 64 * (j))
#define XB_XSUB(j)  (1280 + 64 * (j))
#define XB_XGEN(j)  (2304 + 64 * (j))
#define XB_TOP      3328
#define XB_TOPGEN   3392
#define XCD_BAR_WORDS 3456
#define XB_SPIN_CAP (1u << 22)

__device__ __forceinline__ unsigned xb_ld(unsigned* p)              { return __hip_atomic_load(p, __ATOMIC_RELAXED, __HIP_MEMORY_SCOPE_AGENT); }
__device__ __forceinline__ unsigned xb_add(unsigned* p, unsigned v) { return __hip_atomic_fetch_add(p, v, __ATOMIC_RELAXED, __HIP_MEMORY_SCOPE_AGENT); }
__device__ __forceinline__ unsigned xb_xcc_id() { return (unsigned)__builtin_amdgcn_s_getreg((3 << 11) | 20) & 0xFu; }
#define XB_SPIN(cond, bar) do { unsigned _sp = 0; while (cond) { __builtin_amdgcn_s_sleep(1); \
    if ((++_sp & 255u) == 0u) { if (xb_ld(&(bar)[XB_TMO])) break; if (_sp > XB_SPIN_CAP) { atomicAdd(&(bar)[XB_TMO], 1u); break; } } } } while (0)

struct XcdBarrier { unsigned* bar; unsigned x; volatile LAS unsigned* st; };

__device__ __forceinline__ XcdBarrier xcd_barrier_post(unsigned* bar, volatile LAS unsigned* st) {
    XcdBarrier b; b.bar = bar; b.x = xb_xcc_id(); b.st = st;
    if (threadIdx.x == 0) (void)xb_add(&bar[XB_XCNT(b.x)], 1u);
    return b;
}
__device__ __forceinline__ void xcd_barrier_complete(unsigned* bar, unsigned x, unsigned& nloc, unsigned& nx) {
    const unsigned G = gridDim.x * gridDim.y * gridDim.z;
    unsigned sum, cnt, mine, sp = 0u;
    for (;;) {
        sum = 0u; cnt = 0u; mine = 0u;
#pragma unroll
        for (unsigned j = 0; j < 16; ++j) { const unsigned c = xb_ld(&bar[XB_XCNT(j)]); sum += c; cnt += (c > 0u) ? 1u : 0u; mine = (j == x) ? c : mine; }
        if (sum == G) break;
        __builtin_amdgcn_s_sleep(1);
        if ((++sp & 255u) == 0u) { if (xb_ld(&bar[XB_TMO])) break; if (sp > XB_SPIN_CAP) { atomicAdd(&bar[XB_TMO], 1u); break; } }
    }
    nloc = mine > 0u ? mine : 1u; nx = cnt > 0u ? cnt : 1u;
}
__device__ __forceinline__ void xcd_barrier(const XcdBarrier& b) {
    asm volatile("s_waitcnt vmcnt(0)" ::: "memory");
    __syncthreads();
    if (threadIdx.x == 0) {
        unsigned* bar = b.bar;
        __builtin_amdgcn_s_waitcnt(0);
        unsigned nloc = b.st[0], nx = b.st[1];
        if (nloc == 0u) { xcd_barrier_complete(bar, b.x, nloc, nx); b.st[0] = nloc; b.st[1] = nx; }
        const unsigned old = xb_add(&bar[XB_XSUB(b.x)], 1u);
        const unsigned gen = old / nloc;
        if (old + 1u == (gen + 1u) * nloc) {
            __builtin_amdgcn_fence(__ATOMIC_RELEASE, "agent");
            asm volatile("s_waitcnt vmcnt(0)" ::: "memory");
            const unsigned og = xb_add(&bar[XB_TOP], 1u);
            const unsigned tg = og / nx;
            if (og + 1u == (tg + 1u) * nx) xb_add(&bar[XB_TOPGEN], 1u);
            else XB_SPIN(xb_ld(&bar[XB_TOPGEN]) == tg, bar);
            __builtin_amdgcn_fence(__ATOMIC_ACQUIRE, "agent");
            xb_add(&bar[XB_XGEN(b.x)], 1u);
            asm volatile("s_waitcnt vmcnt(0)" ::: "memory");
        } else {
            XB_SPIN(xb_ld(&bar[XB_XGEN(b.x)]) == gen, bar);
            __builtin_amdgcn_fence(__ATOMIC_ACQUIRE, "agent");
            asm volatile("s_waitcnt vmcnt(0)" ::: "memory");
        }
    }
    __syncthreads();
}

namespace pg8 {
constexpr int BM = 256, BK = 64, HALF = 128, HTB = HALF * BK * 2, STAGE_BYTES = 8 * HTB, NXCD = 8, WGM = 8;
__host__ __device__ __forceinline__ int lds_byte(int r, int c) { const int st = (r >> 4) * 2 + (c >> 5), rr = r & 15, cc = c & 31, ob = rr * 64 + cc * 2; return st * 1024 + (ob ^ (((ob >> 9) & 1) << 5)); }
__host__ __device__ __forceinline__ void stage_rc(int b, int& R, int& C) { const int st = b / 1024, sb = b % 1024, swz = sb ^ (((sb >> 9) & 1) << 5); R = (st >> 1) * 16 + swz / 64; C = (st & 1) * 32 + (swz % 64) / 2; }
__host__ __device__ __forceinline__ int perm32(int rho) { const int n = rho >> 4, i = rho & 15; return 8 * (i >> 2) + 4 * n + (i & 3); }

struct Unit { const char* A; const char* B; int row0, col0, e; };
struct Gemm { int lda, ldb, K; };

struct DenseOrder {
    int nM, nN, nwg, G, c; const char* A; const char* B; size_t atile, btile;
    __device__ void init(const bf16_t* A_, int lda, const bf16_t* B_, int ldb, int M, int N, int G_, int c_) { nM = M / BM; nN = N / BM; nwg = nM * nN; G = G_; c = c_; A = (const char*)A_; B = (const char*)B_; atile = (size_t)BM * lda * 2; btile = (size_t)BM * ldb * 2; }
    __device__ bool next(int i, Unit& u) const {
        const long L = (long)i * G + c; if (L >= nwg) return false;
        int wgid = (int)L; { const int q = nwg / NXCD, r = nwg % NXCD, xcd = wgid % NXCD, off = wgid / NXCD; wgid = (xcd < r ? xcd * (q + 1) : r * (q + 1) + (xcd - r) * q) + off; }
        const int nig = WGM * nN, gid = wgid / nig, fm = gid * WGM, gsz = (nM - fm) < WGM ? (nM - fm) : WGM;
        const int pm = fm + ((wgid % nig) % gsz), pn = (wgid % nig) / gsz;
        u.row0 = pm * BM; u.col0 = pn * BM; u.e = 0; u.A = A + (size_t)pm * atile; u.B = B + (size_t)pn * btile; return true;
    }
};
struct GroupedOrder {
    const int* tile_e; int ntiles, nN, G, c; const char* A; const char* B; size_t atile, btile, bexp;
    __device__ bool next(int i, Unit& u) const {
        const long L = (long)i * G + c; if (L >= (long)ntiles * nN) return false;
        const int ti = (int)(L / nN), pn = (int)(L % nN);
        const int e = __builtin_amdgcn_readfirstlane(ld_agent_i(tile_e + ti));
        u.row0 = ti * BM; u.col0 = pn * BM; u.e = e; u.A = A + (size_t)ti * atile; u.B = B + (size_t)e * bexp + (size_t)pn * btile; return true;
    }
};

typedef f32x4 Acc[2][2][4][2];
__device__ __forceinline__ u32x4 pack8(f32x4 a, f32x4 b) { u32x4 w; w.x = cvtpk(a[0], a[1]); w.y = cvtpk(a[2], a[3]); w.z = cvtpk(b[0], b[1]); w.w = cvtpk(b[2], b[3]); return w; }
__device__ __forceinline__ void unpack8(u32x4 w, f32x4& a, f32x4& b) { a = (f32x4){bflo(w.x), bfhi(w.x), bflo(w.y), bfhi(w.y)}; b = (f32x4){bflo(w.z), bfhi(w.z), bflo(w.w), bfhi(w.w)}; }

struct EpiStore {
    static constexpr bool PERM = true; bf16_t* O; int ldc;
    __device__ __forceinline__ void operator()(const Acc& acc, const Unit& u, int wr, int wc, int fr, int fq) const {
        const int row0 = u.row0 + wr * 64 + fr, col0 = u.col0 + wc * 32 + 8 * fq;
#pragma unroll
        for (int ai = 0; ai < 2; ++ai)
#pragma unroll
            for (int m = 0; m < 4; ++m) { bf16_t* rowp = O + (size_t)(row0 + ai * HALF + m * 16) * ldc + col0;
#pragma unroll
                for (int bj = 0; bj < 2; ++bj) *(u32x4*)(rowp + bj * HALF) = pack8(acc[ai][bj][m][0], acc[ai][bj][m][1]); }
    }
};
struct EpiQRope {
    static constexpr bool PERM = true; bf16_t* O; int ldc; const f32x4* rope;
    __device__ __forceinline__ void operator()(const Acc& acc, const Unit& u, int wr, int wc, int fr, int fq) const {
        const int row0 = u.row0 + wr * 64 + fr, col0 = u.col0 + wc * 32 + 8 * fq;
#pragma unroll
        for (int ai = 0; ai < 2; ++ai)
#pragma unroll
            for (int m = 0; m < 4; ++m) { const int row = row0 + ai * HALF + m * 16, pos = row & (SEQ - 1); bf16_t* rowp = O + (size_t)row * ldc + col0;
#pragma unroll
                for (int bj = 0; bj < 2; ++bj) { f32x4 v0 = acc[ai][bj][m][0], v1 = acc[ai][bj][m][1]; const int d = (col0 + bj * HALF) % 192;
                    if (d >= 128) { const int jj = (d - 128) >> 1; const f32x4 c01 = rope[pos * 16 + (jj >> 1)], c23 = rope[pos * 16 + (jj >> 1) + 1];
                        f32x4 w0, w1;
                        w0[0] = v0[0] * c01[0] - v0[1] * c01[1]; w0[1] = v0[0] * c01[1] + v0[1] * c01[0];
                        w0[2] = v0[2] * c01[2] - v0[3] * c01[3]; w0[3] = v0[2] * c01[3] + v0[3] * c01[2];
                        w1[0] = v1[0] * c23[0] - v1[1] * c23[1]; w1[1] = v1[0] * c23[1] + v1[1] * c23[0];
                        w1[2] = v1[2] * c23[2] - v1[3] * c23[3]; w1[3] = v1[2] * c23[3] + v1[3] * c23[2];
                        v0 = w0; v1 = w1; }
                    *(u32x4*)(rowp + bj * HALF) = pack8(v0, v1); } }
    }
};
template <bool HAS_PREV> struct EpiGate {
    static constexpr bool PERM = true; const bf16_t* G; int ldg; const bf16_t* prev; bf16_t* O; int ldc;
    __device__ __forceinline__ void operator()(const Acc& acc, const Unit& u, int wr, int wc, int fr, int fq) const {
        const int row0 = u.row0 + wr * 64 + fr, col0 = u.col0 + wc * 32 + 8 * fq;
#pragma unroll
        for (int ai = 0; ai < 2; ++ai)
#pragma unroll
            for (int m = 0; m < 4; ++m) { const int row = row0 + ai * HALF + m * 16;
#pragma unroll
                for (int bj = 0; bj < 2; ++bj) { const int col = col0 + bj * HALF;
                    f32x4 g0, g1; unpack8(*(const u32x4*)(G + (size_t)row * ldg + col), g0, g1);
                    f32x4 v0 = acc[ai][bj][m][0], v1 = acc[ai][bj][m][1];
#pragma unroll
                    for (int j = 0; j < 4; ++j) { v0[j] *= sigmoidf_(g0[j]); v1[j] *= sigmoidf_(g1[j]); }
                    if (HAS_PREV) { f32x4 p0, p1; unpack8(*(const u32x4*)(prev + (size_t)row * ldc + col), p0, p1); v0 += p0; v1 += p1; }
                    *(u32x4*)(O + (size_t)row * ldc + col) = pack8(v0, v1); } }
    }
};
struct EpiResF32 {
    static constexpr bool PERM = false; const float* base; float* C; int ldc;
    __device__ __forceinline__ void operator()(const Acc& acc, const Unit& u, int wr, int wc, int fr, int fq) const {
        const int row0 = u.row0 + wr * 64 + fr, col0 = u.col0 + wc * 32 + 4 * fq;
#pragma unroll
        for (int ai = 0; ai < 2; ++ai)
#pragma unroll
            for (int m = 0; m < 4; ++m) { const size_t off = (size_t)(row0 + ai * HALF + m * 16) * ldc + col0;
#pragma unroll
                for (int bj = 0; bj < 2; ++bj)
#pragma unroll
                    for (int n = 0; n < 2; ++n) { const f32x4 b = base ? *(const f32x4*)(base + off + bj * HALF + n * 16) : (f32x4){0.f, 0.f, 0.f, 0.f}; *(f32x4*)(C + off + bj * HALF + n * 16) = b + acc[ai][bj][m][n]; } }
    }
};
struct EpiSwiglu {
    static constexpr bool PERM = true; const float* bg; const float* bu; bf16_t* O;
    __device__ __forceinline__ void operator()(const Acc& acc, const Unit& u, int wr, int wc, int fr, int fq) const {
        const int row0 = u.row0 + wr * 64 + fr, hc = (u.col0 >> 1) + wc * 32 + 8 * fq;
        const float* bgp = bg + (size_t)u.e * DM + hc; const float* bup = bu + (size_t)u.e * DM + hc;
        const f32x4 bg0 = *(const f32x4*)bgp, bg1 = *(const f32x4*)(bgp + 4), bu0 = *(const f32x4*)bup, bu1 = *(const f32x4*)(bup + 4);
#pragma unroll
        for (int ai = 0; ai < 2; ++ai)
#pragma unroll
            for (int m = 0; m < 4; ++m) { f32x4 g0 = acc[ai][0][m][0] + bg0, g1 = acc[ai][0][m][1] + bg1, u0 = acc[ai][1][m][0] + bu0, u1 = acc[ai][1][m][1] + bu1, r0, r1;
#pragma unroll
                for (int j = 0; j < 4; ++j) {
                    const float ga = fminf(g0[j], 7.0f), gb = fminf(g1[j], 7.0f);
                    const float ua = fminf(fmaxf(u0[j], -7.0f), 7.0f), ub = fminf(fmaxf(u1[j], -7.0f), 7.0f);
                    r0[j] = ga * sigmoidf_(1.702f * ga) * (ua + 1.0f); r1[j] = gb * sigmoidf_(1.702f * gb) * (ub + 1.0f); }
                *(u32x4*)(O + (size_t)(row0 + ai * HALF + m * 16) * DM + hc) = pack8(r0, r1); }
    }
};
struct EpiDown {
    static constexpr bool PERM = true; const float* bd; bf16_t* O;
    __device__ __forceinline__ void operator()(const Acc& acc, const Unit& u, int wr, int wc, int fr, int fq) const {
        const int row0 = u.row0 + wr * 64 + fr, col0 = u.col0 + wc * 32 + 8 * fq;
        const float* bp = bd + (size_t)u.e * DM + col0;
        f32x4 bv[2][2];
#pragma unroll
        for (int bj = 0; bj < 2; ++bj) { bv[bj][0] = *(const f32x4*)(bp + bj * HALF); bv[bj][1] = *(const f32x4*)(bp + bj * HALF + 4); }
#pragma unroll
        for (int ai = 0; ai < 2; ++ai)
#pragma unroll
            for (int m = 0; m < 4; ++m) { bf16_t* rowp = O + (size_t)(row0 + ai * HALF + m * 16) * DM + col0;
#pragma unroll
                for (int bj = 0; bj < 2; ++bj) *(u32x4*)(rowp + bj * HALF) = pack8(acc[ai][bj][m][0] + bv[bj][0], acc[ai][bj][m][1] + bv[bj][1]); }
    }
};
struct EpiPle {
    static constexpr bool PERM = false; const float* h; const float* emb; float* out;
    __device__ __forceinline__ void operator()(const Acc& acc, const Unit& u, int wr, int wc, int fr, int fq) const {
        const int row0 = u.row0 + wr * 64 + fr, col0 = u.col0 + wc * 32 + 4 * fq;
#pragma unroll
        for (int ai = 0; ai < 2; ++ai)
#pragma unroll
            for (int m = 0; m < 4; ++m) { const size_t off = (size_t)(row0 + ai * HALF + m * 16) * DM + col0;
#pragma unroll
                for (int bj = 0; bj < 2; ++bj)
#pragma unroll
                    for (int n = 0; n < 2; ++n) { const size_t o = off + bj * HALF + n * 16; const f32x4 hv = *(const f32x4*)(h + o), ev = *(const f32x4*)(emb + o); f32x4 a = acc[ai][bj][m][n], r;
#pragma unroll
                        for (int j = 0; j < 4; ++j) r[j] = hv[j] + ev[j] * sigmoidf_(a[j]);
                        *(f32x4*)(out + o) = r; } }
    }
};

template <class Epi, class Sched>
__device__ __forceinline__ void gemm_phase(LAS unsigned char* lds, const Gemm g, const Sched& S, const Epi& E) {
    const int tid = threadIdx.x, wid = __builtin_amdgcn_readfirstlane(tid >> 6), lane = tid & 63, wr = wid >> 2, wc = wid & 3, fr = lane & 15, fq = lane >> 4;
    const int nt = g.K / BK;
    unsigned voffA[2], voffB[2];
#pragma unroll
    for (int i = 0; i < 2; ++i) { int R, C; stage_rc(tid * 16 + i * 8192, R, C); const int Rb = Epi::PERM ? ((R & ~31) + perm32(R & 31)) : R;
        voffA[i] = (unsigned)(R * g.lda + C) * 2u; voffB[i] = (unsigned)(Rb * g.ldb + C) * 2u; }
    const size_t kstep = (size_t)(BK * 2);
    const size_t hstepA = (size_t)HALF * g.lda * 2, hstepB = (size_t)HALF * g.ldb * 2;
    const unsigned ldsw = (unsigned)wid * 1024u;
    const int aoff = lds_byte(wr * 64 + fr, fq * 8), boff = lds_byte(wc * 32 + fr, fq * 8);
#define PG8_SA(b, h) (((b) * 2 + (h)) * HTB)
#define PG8_SB(b, h) ((4 + (b) * 2 + (h)) * HTB)
#define PG8_STAGE(bufoff, gbase, voff) do { _Pragma("unroll") for (int _i = 0; _i < 2; ++_i) \
        __builtin_amdgcn_global_load_lds((const unsigned*)((const char*)(gbase) + (voff)[_i]), (LAS unsigned*)(lds + (bufoff) + ldsw + _i * 8192), 16, 0, 0); } while (0)
#define PG8_LDA(dst, b, h) do { _Pragma("unroll") for (int m = 0; m < 4; ++m) _Pragma("unroll") for (int k = 0; k < 2; ++k) dst[m][k] = *(const LAS bf16x8*)(lds + PG8_SA(b, h) + aoff + m * 2048 + k * 1024); } while (0)
#define PG8_LDB(dst, b, h) do { _Pragma("unroll") for (int n = 0; n < 2; ++n) _Pragma("unroll") for (int k = 0; k < 2; ++k) dst[n][k] = *(const LAS bf16x8*)(lds + PG8_SB(b, h) + boff + n * 2048 + k * 1024); } while (0)
#define PG8_MMA(ai, bj, At, Bt) do { __builtin_amdgcn_s_setprio(1); _Pragma("unroll") for (int m = 0; m < 4; ++m) _Pragma("unroll") for (int n = 0; n < 2; ++n) _Pragma("unroll") for (int k = 0; k < 2; ++k) \
        acc[ai][bj][m][n] = __builtin_amdgcn_mfma_f32_16x16x32_bf16(Bt[n][k], At[m][k], acc[ai][bj][m][n], 0, 0, 0); __builtin_amdgcn_s_setprio(0); } while (0)
#define PG8_WAIT_V(n) asm volatile("s_waitcnt vmcnt(" #n ")" ::: "memory")
#define PG8_WAIT_L(n) asm volatile("s_waitcnt lgkmcnt(" #n ")" ::: "memory")
#define PG8_BAR __builtin_amdgcn_s_barrier()
#define PG8_SCHED __builtin_amdgcn_sched_barrier(0)
    Unit cur, nxt; int ui = 0;
    if (!S.next(0, cur)) return;
    f32x4 acc[2][2][4][2];
#pragma unroll
    for (int a = 0; a < 2; ++a)
#pragma unroll
        for (int b = 0; b < 2; ++b)
#pragma unroll
            for (int m = 0; m < 4; ++m)
#pragma unroll
                for (int n = 0; n < 2; ++n) acc[a][b][m][n] = (f32x4){0.f, 0.f, 0.f, 0.f};
    bf16x8 At[4][2], B0[2][2], B1[2][2];
    const char* cA = cur.A; const char* cB = cur.B;
    PG8_STAGE(PG8_SB(0, 0), cB, voffB); PG8_STAGE(PG8_SB(0, 1), cB + hstepB, voffB); PG8_STAGE(PG8_SA(0, 0), cA, voffA); PG8_STAGE(PG8_SA(0, 1), cA + hstepA, voffA);
    if (wr == 1) PG8_BAR;
    PG8_WAIT_V(2); PG8_BAR;
    PG8_STAGE(PG8_SB(1, 0), cB + kstep, voffB); PG8_STAGE(PG8_SA(1, 0), cA + kstep, voffA); PG8_STAGE(PG8_SB(1, 1), cB + hstepB + kstep, voffB);
    PG8_WAIT_V(6); PG8_BAR;
    for (;;) {
        const bool has_next = S.next(ui + 1, nxt);
        const char* nA = has_next ? nxt.A : cA; const char* nB = has_next ? nxt.B : cB;
        for (int t = 0; t < nt; t += 2) {
            const bool last = (t == nt - 2);
            const char* a1 = cA + (size_t)(t + 1) * kstep;
            const char* a2 = last ? nA : cA + (size_t)(t + 2) * kstep; const char* b2 = last ? nB : cB + (size_t)(t + 2) * kstep;
            const char* a3 = a2 + kstep; const char* b3 = b2 + kstep;
            PG8_LDB(B0, 0, 0); PG8_LDB(B1, 0, 1); PG8_SCHED; PG8_LDA(At, 0, 0); PG8_STAGE(PG8_SA(1, 1), a1 + hstepA, voffA);
            PG8_WAIT_V(8); PG8_WAIT_L(0); PG8_BAR; PG8_MMA(0, 0, At, B0); PG8_MMA(0, 1, At, B1); PG8_BAR; PG8_SCHED;
            PG8_LDA(At, 0, 1); PG8_STAGE(PG8_SB(0, 0), b2, voffB); PG8_STAGE(PG8_SB(0, 1), b2 + hstepB, voffB); PG8_STAGE(PG8_SA(0, 0), a2, voffA);
            PG8_WAIT_V(8); PG8_WAIT_L(0); PG8_BAR; PG8_MMA(1, 0, At, B0); PG8_MMA(1, 1, At, B1); PG8_BAR; PG8_SCHED;
            PG8_LDB(B0, 1, 0); PG8_LDB(B1, 1, 1); PG8_SCHED; PG8_LDA(At, 1, 0); PG8_STAGE(PG8_SA(0, 1), a2 + hstepA, voffA);
            PG8_WAIT_V(8); PG8_WAIT_L(0); PG8_BAR; PG8_MMA(0, 0, At, B0); PG8_MMA(0, 1, At, B1); PG8_BAR; PG8_SCHED;
            PG8_LDA(At, 1, 1); PG8_STAGE(PG8_SB(1, 0), b3, voffB); PG8_STAGE(PG8_SB(1, 1), b3 + hstepB, voffB); PG8_STAGE(PG8_SA(1, 0), a3, voffA);
            PG8_WAIT_V(8); PG8_WAIT_L(0); PG8_BAR; PG8_MMA(1, 0, At, B0); PG8_MMA(1, 1, At, B1); PG8_BAR; PG8_SCHED;
        }
        if (wr == 0) PG8_BAR;
        E(acc, cur, wr, wc, fr, fq);
        if (!has_next) break;
#pragma unroll
        for (int a = 0; a < 2; ++a)
#pragma unroll
            for (int b = 0; b < 2; ++b)
#pragma unroll
                for (int m = 0; m < 4; ++m)
#pragma unroll
                    for (int n = 0; n < 2; ++n) acc[a][b][m][n] = (f32x4){0.f, 0.f, 0.f, 0.f};
        cur = nxt; cA = nA; cB = nB; ++ui;
        if (wr == 1) PG8_BAR;
    }
    PG8_WAIT_V(0);
    PG8_BAR;
#undef PG8_SA
#undef PG8_SB
#undef PG8_STAGE
#undef PG8_LDA
#undef PG8_LDB
#undef PG8_MMA
#undef PG8_WAIT_V
#undef PG8_WAIT_L
#undef PG8_BAR
#undef PG8_SCHED
}
}

namespace att {
constexpr int SHM_V = 64 * 128 * 2, SHM_KN = 64 * 128 * 2, SHM_KR = 64 * 64 * 2;
constexpr int OFF_KN = 2 * SHM_V, OFF_KR = OFF_KN + 2 * SHM_KN, OFF_WS = OFF_KR + 2 * SHM_KR, OFF_SEL = OFF_WS + 8 * 64 * 4, OFF_BT = OFF_SEL + 1024, OFF_KM = OFF_BT + 1024, ATT_LDS = OFF_KM + 8192;
static_assert(ATT_LDS <= RING_BYTES, "attention LDS");
__device__ __forceinline__ int v_rd_base(int lane) { return ((lane & 3) << 3) | (((lane >> 2) & 3) << 6) | (((lane >> 4) & 1) << 5) | (((lane >> 5) & 1) << 8); }
__device__ __forceinline__ int crow(int r, int hi) { return (r & 3) + 8 * (r >> 2) + 4 * hi; }
#define CROWC(r) (((r) & 3) + 8 * ((r) >> 2))
#define SBAR() __builtin_amdgcn_sched_barrier(0)

template <bool MLA>
__device__ __forceinline__ void attn_unit(char* lds, int h, int qb, const bf16_t* Qp, int ldq, const bf16_t* Kp, int ldk, const bf16_t* KRp, const bf16_t* Vp, int ldv,
                                          bf16_t* Op, int ldo, const float* KMp, const float* rel_bias) {
    constexpr int DK = MLA ? 192 : 128, NQ = DK / 16;
    constexpr float SCALE = MLA ? 0.07216878364870323f : 0.08838834764831845f;
    constexpr float C2 = 1.4426950408889634f * SCALE, THR = 8.f;
    const float NEG = -__builtin_inff();
    const int tid = threadIdx.x, wid = __builtin_amdgcn_readfirstlane(tid >> 6), lane = tid & 63, r32 = lane & 31, hi = lane >> 5;
    float* wsf = (float*)(lds + OFF_WS) + wid * 64; float* li_l = wsf; float* al_l = wsf + 32; const float* al_h = al_l + 4 * hi; const float* li_h = li_l + 4 * hi;
    unsigned* sel_l = (unsigned*)(lds + OFF_SEL); float* bt_l = (float*)(lds + OFF_BT); float* km_l = (float*)(lds + OFF_KM);
    const int q0 = qb * 256, qlo = q0 + wid * 32, qpos = qlo + r32, NT = (qb + 1) * 4;
    unsigned offKn[2], offV[2], offKr;
#pragma unroll
    for (int i = 0; i < 2; ++i) { const int pc = wid * 2 + i;
        { const int row = pc * 4 + (lane >> 4), colB = ((lane & 15) * 16) ^ ((row & 7) << 4); offKn[i] = (unsigned)(row * ldk + (colB >> 1)); }
        { const int sub = pc * 2 + (lane >> 5), kk = (sub >> 2) * 8 + ((lane & 31) >> 2), c = (sub & 3) * 32 + (lane & 3) * 8; const int k = (kk & ~0xC) | ((kk & 4) << 1) | ((kk & 8) >> 1);
          offV[i] = (unsigned)(k * ldv + c); } }
    { const int row = wid * 8 + (lane >> 3), colB = ((lane & 7) * 16) ^ ((row & 7) << 4); offKr = (unsigned)(row * 64 + (colB >> 1)); }
#define A_ISSUE(kb, buf) do { \
        _Pragma("unroll") for (int i_ = 0; i_ < 2; ++i_) { \
            __builtin_amdgcn_global_load_lds((const unsigned*)(Kp + (size_t)(kb) * ldk + offKn[i_]), (LAS unsigned*)(lds + OFF_KN + (buf) * SHM_KN + (wid * 2 + i_) * 1024), 16, 0, 0); \
            __builtin_amdgcn_global_load_lds((const unsigned*)(Vp + (size_t)(kb) * ldv + offV[i_]), (LAS unsigned*)(lds + (buf) * SHM_V + (wid * 2 + i_) * 1024), 16, 0, 0); } \
        if constexpr (MLA) __builtin_amdgcn_global_load_lds((const unsigned*)(KRp + (size_t)(kb) * 64 + offKr), (LAS unsigned*)(lds + OFF_KR + (buf) * SHM_KR + wid * 1024), 16, 0, 0); } while (0)
    A_ISSUE(0, 0);
    bf16x8 qr[NQ];
    { const bf16_t* qrow = Qp + (size_t)qpos * ldq;
#pragma unroll
      for (int d0 = 0; d0 < NQ; ++d0) qr[d0] = *(const bf16x8*)(qrow + d0 * 16 + hi * 8); }
    unsigned mysel = 0u;
    if constexpr (!MLA) {
        if (tid <= 128) { const int n = tid; int bk; if (n < 16) bk = n; else { const float v = logf((float)n * (1.0f / 16.0f)) / logf(8.0f) * 16.0f; bk = 16 + (int)v; if (bk > 31) bk = 31; }
            bt_l[tid] = rel_bias[bk * 8 + h] * (1.0f / SCALE); }
        for (int i = tid; i < 16 * 128; i += 512) km_l[i] = KMp[i];
        __syncthreads();
        { const int row = tid >> 1, half = tid & 1;
          unsigned mask;
          if (qb <= 3) mask = (1u << qb) - 1u;
          else { const bf16_t* qrow = Qp + (size_t)(q0 + row) * ldq + half * 64;
              u32x4 qv[8];
#pragma unroll
              for (int c = 0; c < 8; ++c) qv[c] = *(const u32x4*)(qrow + c * 8);
              float v0 = NEG, v1 = NEG, v2 = NEG; int i0 = 0, i1 = 0, i2 = 0;
#pragma unroll 1
              for (int n = 0; n < qb; ++n) { const float* kp = km_l + n * 128 + half * 64; float x = 0.f;
#pragma unroll
                  for (int c = 0; c < 8; ++c) { const f32x4 k0 = *(const f32x4*)(kp + c * 8), k1 = *(const f32x4*)(kp + c * 8 + 4);
                      x += bflo(qv[c].x) * k0[0] + bfhi(qv[c].x) * k0[1] + bflo(qv[c].y) * k0[2] + bfhi(qv[c].y) * k0[3] + bflo(qv[c].z) * k1[0] + bfhi(qv[c].z) * k1[1] + bflo(qv[c].w) * k1[2] + bfhi(qv[c].w) * k1[3]; }
                  x += __shfl_xor(x, 1);
                  if (x > v0) { v2 = v1; i2 = i1; v1 = v0; i1 = i0; v0 = x; i0 = n; } else if (x > v1) { v2 = v1; i2 = i1; v1 = x; i1 = n; } else if (x > v2) { v2 = x; i2 = n; } }
              mask = (1u << i0) | (1u << i1) | (1u << i2); }
          if (half == 0) sel_l[row] = mask; }
        __syncthreads();
        mysel = sel_l[wid * 32 + r32];
    }
    float m_reg = -1e30f, l_reg = 0.f; f32x16 o[4];
#pragma unroll
    for (int d = 0; d < 4; ++d)
#pragma unroll
        for (int r = 0; r < 16; ++r) o[d][r] = 0.f;
    int kan[4], kar[4];
#pragma unroll
    for (int dd = 0; dd < 4; ++dd) { kan[dd] = OFF_KN + r32 * 256 + ((dd * 32 + hi * 16) ^ ((r32 & 7) << 4)); kar[dd] = OFF_KR + r32 * 128 + ((dd * 32 + hi * 16) ^ ((r32 & 7) << 4)); }
    const int vrb = (int)(uintptr_t)lds + v_rd_base(lane);
    VM_WAIT(); __syncthreads();
    for (int t = 0; t < NT; ++t) {
        const int buf = t & 1, kb = t * 64, jb = kb >> 8;
        if (t + 1 < NT) A_ISSUE(kb + 64, buf ^ 1);
        int act;
        if (MLA || jb == qb) act = (kb <= qlo + 31) ? 1 : 0; else act = __any((int)((mysel >> jb) & 1u)) ? 1 : 0;
        act = __builtin_amdgcn_readfirstlane(act);
        if (act) {
            f32x16 p0, p1;
#pragma unroll
            for (int r = 0; r < 16; ++r) { p0[r] = 0.f; p1[r] = 0.f; }
            { const char* kn = lds + buf * SHM_KN; const char* kr = lds + buf * SHM_KR;
#pragma unroll
              for (int d0 = 0; d0 < 8; ++d0) { const char* ap = kn + kan[d0 & 3] + (d0 >> 2) * 128;
                  const bf16x8 a0 = *(const bf16x8*)ap, a1 = *(const bf16x8*)(ap + 32 * 256);
                  p0 = __builtin_amdgcn_mfma_f32_32x32x16_bf16(a0, qr[d0], p0, 0, 0, 0);
                  p1 = __builtin_amdgcn_mfma_f32_32x32x16_bf16(a1, qr[d0], p1, 0, 0, 0); }
              if constexpr (MLA) {
#pragma unroll
                  for (int d0 = 8; d0 < 12; ++d0) { const char* ap = kr + kar[d0 & 3];
                      const bf16x8 a0 = *(const bf16x8*)ap, a1 = *(const bf16x8*)(ap + 32 * 128);
                      p0 = __builtin_amdgcn_mfma_f32_32x32x16_bf16(a0, qr[d0], p0, 0, 0, 0);
                      p1 = __builtin_amdgcn_mfma_f32_32x32x16_bf16(a1, qr[d0], p1, 0, 0, 0); } } }
            const int dq = qpos - kb - 4 * hi;
            if constexpr (MLA) {
                if (kb + 63 > qlo) {
#pragma unroll
                    for (int r = 0; r < 16; ++r) { const int d0 = dq - CROWC(r); if (d0 < 0) p0[r] = NEG; if (d0 < 32) p1[r] = NEG; } }
            } else {
                const bool selq = (jb == qb) || (((mysel >> jb) & 1u) != 0u);
                if (q0 - (kb + 63) >= 128) { const float cb = bt_l[128];
#pragma unroll
                    for (int r = 0; r < 16; ++r) { p0[r] = selq ? p0[r] + cb : NEG; p1[r] = selq ? p1[r] + cb : NEG; } }
                else {
#pragma unroll
                    for (int r4 = 0; r4 < 4; ++r4) {
#pragma unroll
                        for (int rr = 0; rr < 4; ++rr) { const int r = r4 * 4 + rr; const int d0 = dq - CROWC(r), d1 = d0 - 32;
                            const float b0 = bt_l[d0 < 0 ? 0 : (d0 > 128 ? 128 : d0)], b1 = bt_l[d1 < 0 ? 0 : (d1 > 128 ? 128 : d1)];
                            p0[r] = (selq && d0 >= 0) ? p0[r] + b0 : NEG; p1[r] = (selq && d1 >= 0) ? p1[r] + b1 : NEG; }
                        SBAR(); } }
            }
            float pmax = p0[0];
#pragma unroll
            for (int r = 1; r < 16; ++r) pmax = fmaxf(pmax, p0[r]);
#pragma unroll
            for (int r = 0; r < 16; ++r) pmax = fmaxf(pmax, p1[r]);
            { auto rr = __builtin_amdgcn_permlane32_swap(__float_as_uint(pmax), __float_as_uint(pmax), false, false); pmax = fmaxf(__uint_as_float(rr[0]), __uint_as_float(rr[1])); }
            float mn, alpha;
            if (__all((pmax - m_reg) * SCALE <= THR)) { mn = m_reg; alpha = 1.f; }
            else { mn = fmaxf(m_reg, pmax); alpha = __builtin_amdgcn_exp2f((m_reg - mn) * C2); m_reg = mn; }
            const float mnL = -mn * C2;
#pragma unroll
            for (int r = 0; r < 16; ++r) { p0[r] = __builtin_amdgcn_exp2f(fmaf(p0[r], C2, mnL)); p1[r] = __builtin_amdgcn_exp2f(fmaf(p1[r], C2, mnL)); }
            float ps = 0.f;
#pragma unroll
            for (int r = 0; r < 16; ++r) ps += p0[r];
#pragma unroll
            for (int r = 0; r < 16; ++r) ps += p1[r];
            { auto rr = __builtin_amdgcn_permlane32_swap(__float_as_uint(ps), __float_as_uint(ps), false, false); ps = __uint_as_float(rr[0]) + __uint_as_float(rr[1]); }
            l_reg = l_reg * alpha + ps;
            bf16x8 pa0, pa1, pa2, pa3;
#define PK4(P, B_, OUT) do { unsigned a0_ = cvtpk(P[B_ + 0], P[B_ + 1]), a1_ = cvtpk(P[B_ + 2], P[B_ + 3]); unsigned b0_ = cvtpk(P[B_ + 4], P[B_ + 5]), b1_ = cvtpk(P[B_ + 6], P[B_ + 7]); \
            auto r0_ = __builtin_amdgcn_permlane32_swap(a0_, b0_, false, false); auto r1_ = __builtin_amdgcn_permlane32_swap(a1_, b1_, false, false); \
            u32x4 w_ = {r0_[0], r1_[0], r0_[1], r1_[1]}; OUT = *reinterpret_cast<bf16x8*>(&w_); } while (0)
            PK4(p0, 0, pa0); PK4(p0, 8, pa1); PK4(p1, 0, pa2); PK4(p1, 8, pa3);
#undef PK4
            if (__any(alpha < 1.f)) { if (hi == 0) al_l[r32] = alpha; LDS_WAIT();
#pragma unroll
                for (int r = 0; r < 16; ++r) { const float a = al_h[CROWC(r)];
#pragma unroll
                    for (int d_ = 0; d_ < 4; ++d_) o[d_][r] *= a; } }
            { const int vb0 = vrb + buf * SHM_V;
#define TRRD(dst, off) asm volatile("ds_read_b64_tr_b16 %0, %1 offset:%2" : "=&v"(dst) : "v"(vb0), "i"(off) : "memory")
#define PV_D0(d0) do { s16x4 l0, l1, l2, l3, h0, h1, h2, h3; constexpr int b_ = (d0) * 512; \
            TRRD(l0, b_); TRRD(h0, b_ + 2048); TRRD(l1, b_ + 4096); TRRD(h1, b_ + 6144); TRRD(l2, b_ + 8192); TRRD(h2, b_ + 10240); TRRD(l3, b_ + 12288); TRRD(h3, b_ + 14336); \
            asm volatile("s_waitcnt lgkmcnt(0)" ::: "memory"); SBAR(); \
            o[d0] = __builtin_amdgcn_mfma_f32_32x32x16_bf16(pa0, (bf16x8){l0[0], l0[1], l0[2], l0[3], h0[0], h0[1], h0[2], h0[3]}, o[d0], 0, 0, 0); \
            o[d0] = __builtin_amdgcn_mfma_f32_32x32x16_bf16(pa1, (bf16x8){l1[0], l1[1], l1[2], l1[3], h1[0], h1[1], h1[2], h1[3]}, o[d0], 0, 0, 0); \
            o[d0] = __builtin_amdgcn_mfma_f32_32x32x16_bf16(pa2, (bf16x8){l2[0], l2[1], l2[2], l2[3], h2[0], h2[1], h2[2], h2[3]}, o[d0], 0, 0, 0); \
            o[d0] = __builtin_amdgcn_mfma_f32_32x32x16_bf16(pa3, (bf16x8){l3[0], l3[1], l3[2], l3[3], h3[0], h3[1], h3[2], h3[3]}, o[d0], 0, 0, 0); SBAR(); } while (0)
              PV_D0(0); PV_D0(1); PV_D0(2); PV_D0(3);
#undef PV_D0
#undef TRRD
            }
        }
        VM_WAIT();
        __syncthreads();
    }
#undef A_ISSUE
    if (hi == 0) li_l[r32] = l_reg; LDS_WAIT();
    bf16_t* Ow = Op + (size_t)qlo * ldo;
#pragma unroll
    for (int r = 0; r < 16; ++r) { const int orow = CROWC(r) + 4 * hi; const float rl = __builtin_amdgcn_rcpf(li_h[CROWC(r)]);
#pragma unroll
        for (int d0 = 0; d0 < 4; ++d0) { const float v = o[d0][r] * rl; const float vn = __shfl_xor(v, 1);
            if ((r32 & 1) == 0) *(unsigned*)(Ow + (size_t)orow * ldo + d0 * 32 + r32) = cvtpk(v, vn); } }
    __syncthreads();
}
}

struct Args { const float* in[25]; float* out; unsigned char* ws; int ph_lo, ph_hi; };
enum { I_X = 0, I_P, I_ATTN_NORM, I_W_IN, I_QLN, I_KVLN, I_W_UQ, I_W_UKV, I_W_O_MLA, I_W_O_MOBA, I_W_OUT, I_REL_BIAS, I_MOE_NORM, I_W_ROUTER, I_B_ROUTER,
       I_W_GATE, I_B_GATE, I_W_UP, I_B_UP, I_W_DOWN, I_B_DOWN, I_PLE_NORM, I_W_PLE_GATE, I_W_PLE, I_FINAL_NORM };

__device__ const double ROPE_REV[32] = {
    1.59154943091895345608e-01, 1.19349370211248861917e-01, 8.94994016088910132600e-02, 6.71150830052272551196e-02, 5.03292121044870352509e-02, 3.77415847174197710556e-02, 2.83021958306233986646e-02, 2.12236527647776604399e-02,
    1.59154943091895338669e-02, 1.19349370211248861917e-02, 8.94994016088910236684e-03, 6.71150830052272533849e-03, 5.03292121044870369856e-03, 3.77415847174197719230e-03, 2.83021958306233986646e-03, 2.12236527647776621747e-03,
    1.59154943091895334333e-03, 1.19349370211248848907e-03, 8.94994016088910128263e-04, 6.71150830052272490481e-04, 5.03292121044870326488e-04, 3.77415847174197686704e-04, 2.83021958306233954120e-04, 2.12236527647776605484e-04,
    1.59154943091895323490e-04, 1.19349370211248848907e-04, 8.94994016088910182474e-05, 6.71150830052272544691e-05, 5.03292121044870353593e-05, 3.77415847174197700256e-05, 2.83021958306233960897e-05, 2.12236527647776591931e-05};

template <int MODE> __device__ __forceinline__ int map_row(int n) {
    if (MODE == 1) return n < 1024 ? n : (n < 1088 ? 8192 + (n - 1024) : n - 64);
    if (MODE == 2) { const int hh = n / 192, d = n % 192; if (d < 128) return n; const int i = d - 128; return hh * 192 + 128 + 2 * (i & 31) + (i >> 5); }
    if (MODE == 3) return (n >> 7) * 256 + (n & 127);
    if (MODE == 4) return (n >> 7) * 256 + 128 + (n & 127);
    return n;
}
template <int MODE> __device__ __forceinline__ void tr_item(const float* W, int ldw, int K, int k0, int n0, bf16_t* WT, LAS float* scr, int lane) {
#pragma unroll
    for (int i = 0; i < 8; ++i) { const int kk = i * 8 + (lane >> 3); const f32x4 v = *(const GAS f32x4*)(W + (size_t)(k0 + kk) * ldw + n0 + (lane & 7) * 4);
        LAS float* s = scr + kk * 33 + (lane & 7) * 4; s[0] = v[0]; s[1] = v[1]; s[2] = v[2]; s[3] = v[3]; }
    LDS_WAIT(); asm volatile("" ::: "memory");
    const int c = lane & 7;
#pragma unroll
    for (int j = 0; j < 4; ++j) { const int n = (lane >> 3) + 8 * j; const LAS float* s = scr + (8 * c) * 33 + n;
        u32x4 o; o.x = cvtpk(s[0 * 33], s[1 * 33]); o.y = cvtpk(s[2 * 33], s[3 * 33]); o.z = cvtpk(s[4 * 33], s[5 * 33]); o.w = cvtpk(s[6 * 33], s[7 * 33]);
        *(GAS u32x4*)(WT + (size_t)map_row<MODE>(n0 + n) * K + k0 + 8 * c) = o; }
    LDS_WAIT(); asm volatile("" ::: "memory");
}
template <int MODE> __device__ __forceinline__ void tr_mat(const float* W, int K, int N, bf16_t* WT, LAS float* scr, int lane, int item) {
    const int nblk = N / 32, kb = item / nblk, nb = item % nblk;
    tr_item<MODE>(W, N, K, kb * 64, nb * 32, WT, scr, lane);
}

__global__ void __launch_bounds__(512, 2) mega_fwd(Args args) {
    extern __shared__ __attribute__((aligned(16))) unsigned char lds_raw[];
    LAS unsigned char* lds = (LAS unsigned char*)lds_raw;
    volatile LAS unsigned* MISC = (volatile LAS unsigned*)(lds + MISC_OFF);
    const int tid = threadIdx.x, lane = tid & 63, wave = __builtin_amdgcn_readfirstlane(tid >> 6);
    const int G = gridDim.x, bx = blockIdx.x;
    unsigned char* ws = args.ws;
    unsigned* ctl = (unsigned*)(ws + WS_CTL);
    for (int u = tid; u < (LDS_BYTES - LDSCTL_OFF) / 4; u += 512) ((LAS unsigned*)(lds + LDSCTL_OFF))[u] = 0u;
    __syncthreads();
    XcdBarrier bar; bar.bar = ctl + CW_BAR; bar.x = 0; bar.st = nullptr;
    if (MK_N_LAUNCHES == 1) bar = xcd_barrier_post(ctl + CW_BAR, MISC + 8);
    const int lo = args.ph_lo, hi = args.ph_hi;
#ifndef PH_MASK
#define PH_MASK 0xFFFF
#endif
#define IN(k) (((PH_MASK >> (k)) & 1) && lo <= (k) && (k) < hi)
#define SEAM(k) do { if (MK_N_LAUNCHES == 1 && IN(k) && IN((k) + 1)) xcd_barrier(bar); } while (0)
    const int gw = bx * 8 + wave, NGW = G * 8;

    const float* x = args.in[I_X];
    bf16_t* XN = (bf16_t*)(ws + WS_XN);
    bf16_t* Z = (bf16_t*)(ws + WS_R1);
    bf16_t* QM = (bf16_t*)(ws + WS_QM); bf16_t* KV = (bf16_t*)(ws + WS_KV); bf16_t* KR = (bf16_t*)(ws + WS_KR);
    bf16_t* YA = (bf16_t*)(ws + WS_YA); bf16_t* YB = (bf16_t*)(ws + WS_YB); bf16_t* M1 = (bf16_t*)(ws + WS_M1); bf16_t* MG = (bf16_t*)(ws + WS_R4);
    float* H1 = (float*)(ws + WS_H1); float* EB = (float*)(ws + WS_R4);
    bf16_t* XG = (bf16_t*)(ws + WS_R1); bf16_t* HACT = (bf16_t*)(ws + WS_R2); bf16_t* YY = (bf16_t*)(ws + WS_R1);
    bf16_t* PB = (bf16_t*)(ws + WS_PB);
    float* ROPE = (float*)(ws + WS_ROPE); float* KM = (float*)(ws + WS_KM);
    int* TILE = (int*)(ws + WS_TILE); int* AE = (int*)(ws + WS_AE); int* AP = (int*)(ws + WS_AP); float* AW = (float*)(ws + WS_AW); int* DEST = (int*)(ws + WS_DEST);
    bf16_t* WIN = (bf16_t*)(ws + WS_WIN); bf16_t* WUQ = (bf16_t*)(ws + WS_WUQ); bf16_t* WUKV = (bf16_t*)(ws + WS_WUKV); bf16_t* WOA = (bf16_t*)(ws + WS_WOA); bf16_t* WOB = (bf16_t*)(ws + WS_WOB);
    bf16_t* WOUT = (bf16_t*)(ws + WS_WOUT); bf16_t* WPG = (bf16_t*)(ws + WS_WPG); bf16_t* WPLE = (bf16_t*)(ws + WS_WPLE); bf16_t* WGU = (bf16_t*)(ws + WS_WGU); bf16_t* WDN = (bf16_t*)(ws + WS_WDN);

    if (IN(0)) {
        LAS float* scr = (LAS float*)(lds + wave * 16384);
        constexpr int I0 = 32 * 258, I1 = 8 * 48, I2 = 8 * 64, I3 = 16 * 64, I4 = 16 * 64, I5 = 32 * 64, I6 = 32 * 64, I7 = 4 * 64, IE = 32 * 64;
        constexpr int NSMALL = I0 + I1 + I2 + I3 + I4 + I5 + I6 + I7, NITEMS = NSMALL + 3 * 32 * IE;
        for (int it = gw; it < NITEMS; it += NGW) {
            int r = it;
            if (r < I0) { tr_mat<1>(args.in[I_W_IN], 2048, 8256, WIN, scr, lane, r); continue; } r -= I0;
            if (r < I1) { tr_mat<2>(args.in[I_W_UQ], 512, 1536, WUQ, scr, lane, r); continue; } r -= I1;
            if (r < I2) { tr_mat<0>(args.in[I_W_UKV], 512, 2048, WUKV, scr, lane, r); continue; } r -= I2;
            if (r < I3) { tr_mat<0>(args.in[I_W_O_MLA], 1024, 2048, WOA, scr, lane, r); continue; } r -= I3;
            if (r < I4) { tr_mat<0>(args.in[I_W_O_MOBA], 1024, 2048, WOB, scr, lane, r); continue; } r -= I4;
            if (r < I5) { tr_mat<0>(args.in[I_W_OUT], 2048, 2048, WOUT, scr, lane, r); continue; } r -= I5;
            if (r < I6) { tr_mat<0>(args.in[I_W_PLE_GATE], 2048, 2048, WPG, scr, lane, r); continue; } r -= I6;
            if (r < I7) { tr_mat<0>(args.in[I_W_PLE], 256, 2048, WPLE, scr, lane, r); continue; } r -= I7;
            const int which = r / (32 * IE), rr = r % (32 * IE), e = rr / IE, item = rr % IE;
            if (which == 0) tr_mat<3>(args.in[I_W_GATE] + (size_t)e * DM * DM, 2048, 2048, WGU + (size_t)e * 4096 * 2048, scr, lane, item);
            else if (which == 1) tr_mat<4>(args.in[I_W_UP] + (size_t)e * DM * DM, 2048, 2048, WGU + (size_t)e * 4096 * 2048, scr, lane, item);
            else tr_mat<0>(args.in[I_W_DOWN] + (size_t)e * DM * DM, 2048, 2048, WDN + (size_t)e * 2048 * 2048, scr, lane, item);
        }
        for (int i = bx * 512 + tid; i < 192 * 2048 / 8; i += G * 512) *(u32x4*)(WIN + (size_t)8256 * 2048 + (size_t)i * 8) = (u32x4){0u, 0u, 0u, 0u};
        { const float* gn = args.in[I_ATTN_NORM];
          for (int m = gw; m < T; m += NGW) { const f32x4* xr = (const f32x4*)(x + (size_t)m * DM) + lane; f32x4 v[8]; float s = 0.f;
#pragma unroll
              for (int j = 0; j < 8; ++j) { v[j] = xr[64 * j]; s += (v[j][0] * v[j][0] + v[j][1] * v[j][1]) + (v[j][2] * v[j][2] + v[j][3] * v[j][3]); }
              const float rstd = 1.0f / sqrtf(wave_sum(s) * (1.0f / DM) + EPS);
              u32x2* o8 = (u32x2*)(XN + (size_t)m * DM) + lane;
#pragma unroll
              for (int j = 0; j < 8; ++j) { const f32x4 gv = ((const f32x4*)gn)[64 * j + lane]; u32x2 w; w.x = cvtpk(v[j][0] * rstd * gv[0], v[j][1] * rstd * gv[1]); w.y = cvtpk(v[j][2] * rstd * gv[2], v[j][3] * rstd * gv[3]); o8[64 * j] = w; } } }
        { const float* p = args.in[I_P];
          for (int i = bx * 512 + tid; i < T * 256 / 8; i += G * 512) { const f32x4 a = *(const f32x4*)(p + (size_t)i * 8), b = *(const f32x4*)(p + (size_t)i * 8 + 4); *(u32x4*)(PB + (size_t)i * 8) = pg8::pack8(a, b); } }
        for (int i = bx * 512 + tid; i < SEQ * 32; i += G * 512) { const int pos = i >> 5, j = i & 31; double rev = (double)pos * ROPE_REV[j]; rev -= floor(rev); const float fr = (float)rev;
            ROPE[2 * i] = __builtin_amdgcn_cosf(fr); ROPE[2 * i + 1] = __builtin_amdgcn_sinf(fr); }
    }
    SEAM(0);

    if (IN(1)) {
        pg8::Gemm g{DM, DM, DM}; pg8::DenseOrder S; S.init(XN, DM, WIN, DM, T, NZ, G, bx);
        pg8::EpiStore E{Z, NZ};
        pg8::gemm_phase<pg8::EpiStore, pg8::DenseOrder>(lds, g, S, E);
    }
    SEAM(1);

    if (IN(2)) {
        const float* gq = args.in[I_QLN]; const float* gk = args.in[I_KVLN];
        for (int m = gw; m < T; m += NGW) { bf16_t* zr = Z + (size_t)m * NZ;
#pragma unroll
            for (int w2 = 0; w2 < 2; ++w2) { bf16_t* p = zr + (w2 ? ZC_KVL : ZC_QL) + lane * 8; const float* gp = (w2 ? gk : gq) + lane * 8;
                f32x4 a, b; pg8::unpack8(*(const u32x4*)p, a, b);
                const float s = (a[0] * a[0] + a[1] * a[1]) + (a[2] * a[2] + a[3] * a[3]) + (b[0] * b[0] + b[1] * b[1]) + (b[2] * b[2] + b[3] * b[3]);
                const float rstd = 1.0f / sqrtf(wave_sum(s) * (1.0f / 512.0f) + EPS);
                const f32x4 g0 = *(const f32x4*)gp, g1 = *(const f32x4*)(gp + 4);
                *(u32x4*)p = pg8::pack8(a * rstd * g0, b * rstd * g1); }
            if (lane < 32) { const int pos = m & (SEQ - 1); const float x1 = bf2f(zr[ZC_KR + lane]), x2 = bf2f(zr[ZC_KR + 32 + lane]); const float c = ROPE[(pos * 32 + lane) * 2], s = ROPE[(pos * 32 + lane) * 2 + 1];
                *(unsigned*)(KR + (size_t)m * 64 + 2 * lane) = cvtpk(x1 * c - x2 * s, x1 * s + x2 * c); } }
        { LAS float* part = (LAS float*)lds;
          for (int it = bx; it < NBATCH * 8 * 16; it += G) { const int b = it >> 7, hh = (it >> 4) & 7, blk = it & 15; const int c8 = tid & 15, rg = tid >> 4;
              const bf16_t* kp = Z + (size_t)(b * SEQ + blk * 256 + rg * 8) * NZ + ZC_KB + hh * 128 + c8 * 8;
              f32x4 s0 = {0.f, 0.f, 0.f, 0.f}, s1 = {0.f, 0.f, 0.f, 0.f};
#pragma unroll
              for (int r = 0; r < 8; ++r) { f32x4 a, bq; pg8::unpack8(*(const u32x4*)(kp + (size_t)r * NZ), a, bq); s0 += a; s1 += bq; }
              *(LAS f32x4*)(part + rg * 128 + c8 * 8) = s0; *(LAS f32x4*)(part + rg * 128 + c8 * 8 + 4) = s1;
              __syncthreads();
              if (tid < 128) { float s = 0.f;
#pragma unroll
                  for (int r = 0; r < 32; ++r) s += part[r * 128 + tid];
                  KM[(size_t)it * 128 + tid] = s * (1.0f / 256.0f); }
              __syncthreads(); } }
    }
    SEAM(2);

    if (IN(3)) {
        { pg8::Gemm g{NZ, 512, 512}; pg8::DenseOrder S; S.init(Z + ZC_QL, NZ, WUQ, 512, T, 1536, G, bx);
          pg8::EpiQRope E{QM, 1536, (const f32x4*)ROPE};
          pg8::gemm_phase<pg8::EpiQRope, pg8::DenseOrder>(lds, g, S, E); }
        { pg8::Gemm g{NZ, 512, 512}; pg8::DenseOrder S; S.init(Z + ZC_KVL, NZ, WUKV, 512, T, 2048, G, bx);
          pg8::EpiStore E{KV, 2048};
          pg8::gemm_phase<pg8::EpiStore, pg8::DenseOrder>(lds, g, S, E); }
    }
    SEAM(3);

    if (IN(4)) {
#ifndef NO_MLA
        for (int it = bx; it < 256; it += G) {
            const int xcd = it & 7, k = it >> 3, bh = xcd * 4 + (k >> 3), pr = k & 7, b = bh >> 3, hh = bh & 7;
#pragma unroll 1
            for (int pass = 0; pass < 2; ++pass) { const int qb = pass ? pr : 15 - pr;
                att::attn_unit<true>((char*)lds_raw, hh, qb, QM + (size_t)b * SEQ * 1536 + hh * 192, 1536, KV + (size_t)b * SEQ * 2048 + hh * 256, 2048, KR + (size_t)b * SEQ * 64,
                                     KV + (size_t)b * SEQ * 2048 + hh * 256 + 128, 2048, YA + (size_t)b * SEQ * 1024 + hh * 128, 1024, nullptr, nullptr); }
        }
#endif
#ifndef NO_MOBA
        for (int it = bx; it < 256; it += G) {
            const int xcd = it & 7, k = it >> 3, bh = xcd * 4 + (k >> 3), pr = k & 7, b = bh >> 3, hh = bh & 7;
            const bf16_t* zb = Z + (size_t)b * SEQ * NZ + hh * 128;
#pragma unroll 1
            for (int pass = 0; pass < 2; ++pass) { const int qb = pass ? pr : 15 - pr;
                att::attn_unit<false>((char*)lds_raw, hh, qb, zb + ZC_QB, NZ, zb + ZC_KB, NZ, nullptr, zb + ZC_VB, NZ, YB + (size_t)b * SEQ * 1024 + hh * 128, 1024,
                                      KM + (size_t)bh * 16 * 128, args.in[I_REL_BIAS]); }
        }
#endif
    }
    SEAM(4);

    if (IN(5)) {
        pg8::Gemm g{1024, 1024, 1024}; pg8::DenseOrder S; S.init(YA, 1024, WOA, 1024, T, DM, G, bx);
        pg8::EpiGate<false> E{Z + ZC_GA, NZ, nullptr, M1, DM};
        pg8::gemm_phase<pg8::EpiGate<false>, pg8::DenseOrder>(lds, g, S, E);
    }
    SEAM(5);
    if (IN(6)) {
        pg8::Gemm g{1024, 1024, 1024}; pg8::DenseOrder S; S.init(YB, 1024, WOB, 1024, T, DM, G, bx);
        pg8::EpiGate<true> E{Z + ZC_GB, NZ, M1, MG, DM};
        pg8::gemm_phase<pg8::EpiGate<true>, pg8::DenseOrder>(lds, g, S, E);
    }
    SEAM(6);
    if (IN(7)) {
        pg8::Gemm g{DM, DM, DM}; pg8::DenseOrder S; S.init(MG, DM, WOUT, DM, T, DM, G, bx);
        pg8::EpiResF32 E{x, H1, DM};
        pg8::gemm_phase<pg8::EpiResF32, pg8::DenseOrder>(lds, g, S, E);
    }
    SEAM(7);

    if (IN(8)) {
        LAS float* xs = (LAS float*)lds;
        LAS float* part = (LAS float*)(lds + 65536);
        LAS float* lg = (LAS float*)(lds + 65536 + 16384);
        const float* gn = args.in[I_MOE_NORM]; const float* wr_ = args.in[I_W_ROUTER]; const float* br = args.in[I_B_ROUTER];
        for (int ch = bx; ch < T / 8; ch += G) {
            const int m = ch * 8 + wave;
            { const f32x4* xr = (const f32x4*)(H1 + (size_t)m * DM) + lane; f32x4 v[8]; float s = 0.f;
#pragma unroll
              for (int j = 0; j < 8; ++j) { v[j] = xr[64 * j]; s += (v[j][0] * v[j][0] + v[j][1] * v[j][1]) + (v[j][2] * v[j][2] + v[j][3] * v[j][3]); }
              const float rstd = 1.0f / sqrtf(wave_sum(s) * (1.0f / DM) + EPS);
              u32x2* o8 = (u32x2*)(XN + (size_t)m * DM) + lane;
#pragma unroll
              for (int j = 0; j < 8; ++j) { const f32x4 gv = ((const f32x4*)gn)[64 * j + lane]; const f32x4 y = v[j] * rstd * gv;
                  u32x2 w; w.x = cvtpk(y[0], y[1]); w.y = cvtpk(y[2], y[3]); o8[64 * j] = w; *(LAS f32x4*)(xs + wave * DM + (64 * j + lane) * 4) = y; } }
            __syncthreads();
            { const int e = tid & 31, ks = tid >> 5; float acc[8];
#pragma unroll
              for (int r = 0; r < 8; ++r) acc[r] = 0.f;
              for (int k4 = 0; k4 < 32; ++k4) { const int k = ks * 128 + k4 * 4;
                  const float w0 = wr_[(size_t)(k + 0) * 32 + e], w1 = wr_[(size_t)(k + 1) * 32 + e], w2 = wr_[(size_t)(k + 2) * 32 + e], w3 = wr_[(size_t)(k + 3) * 32 + e];
#pragma unroll
                  for (int r = 0; r < 8; ++r) { const f32x4 xv = *(const LAS f32x4*)(xs + r * DM + k); acc[r] += xv[0] * w0 + xv[1] * w1 + xv[2] * w2 + xv[3] * w3; } }
#pragma unroll
              for (int r = 0; r < 8; ++r) part[(ks * 8 + r) * 32 + e] = acc[r]; }
            __syncthreads();
            if (tid < 256) { const int r = tid >> 5, e = tid & 31; float s = br[e];
#pragma unroll
                for (int ks = 0; ks < 16; ++ks) s += part[(ks * 8 + r) * 32 + e];
                lg[r * 32 + e] = s; }
            __syncthreads();
            if (tid < 8) { const int tok = ch * 8 + tid; float v0 = -__builtin_inff(), v1 = v0, v2 = v0, v3 = v0; int i0 = 0, i1 = 0, i2 = 0, i3 = 0;
                for (int e = 0; e < 32; ++e) { const float xv = lg[tid * 32 + e];
                    if (xv > v0) { v3 = v2; i3 = i2; v2 = v1; i2 = i1; v1 = v0; i1 = i0; v0 = xv; i0 = e; }
                    else if (xv > v1) { v3 = v2; i3 = i2; v2 = v1; i2 = i1; v1 = xv; i1 = e; }
                    else if (xv > v2) { v3 = v2; i3 = i2; v2 = xv; i2 = e; }
                    else if (xv > v3) { v3 = xv; i3 = e; } }
                const float e1 = __expf(v1 - v0), e2 = __expf(v2 - v0), e3 = __expf(v3 - v0), inv = 1.0f / (1.0f + e1 + e2 + e3);
                const int p0 = (int)atomicAdd(ctl + CW_CNT + 64 * i0, 1u), p1 = (int)atomicAdd(ctl + CW_CNT + 64 * i1, 1u), p2 = (int)atomicAdd(ctl + CW_CNT + 64 * i2, 1u), p3 = (int)atomicAdd(ctl + CW_CNT + 64 * i3, 1u);
                *(int4*)(AE + tok * 4) = make_int4(i0, i1, i2, i3); *(int4*)(AP + tok * 4) = make_int4(p0, p1, p2, p3); *(f32x4*)(AW + tok * 4) = (f32x4){inv, e1 * inv, e2 * inv, e3 * inv}; }
            __syncthreads();
        }
    }
    SEAM(8);

    if (IN(9)) {
        LAS int* pst = (LAS int*)lds;
        if (tid == 0) { int run = 0;
            for (int e = 0; e < NE; ++e) { const int c = (int)__hip_atomic_load(ctl + CW_CNT + 64 * e, RLX_AGENT); pst[e] = run; pst[32 + e] = c; run += (c + 255) & ~255; }
            pst[64] = run >> 8; }
        __syncthreads();
        if (bx == 0) { if (tid == 0) TILE[0] = pst[64];
            if (tid < NE) { const int s = pst[tid] >> 8, n = (pst[32 + tid] + 255) >> 8; for (int i = 0; i < n; ++i) TILE[16 + s + i] = tid; } }
        for (int a = gw; a < NA; a += NGW) { const int tok = a >> 2; const int e = AE[a], dest = pst[e] + AP[a];
            if (lane == 0) DEST[a] = dest;
            const u32x4* src = (const u32x4*)(XN + (size_t)tok * DM) + lane; u32x4* dst = (u32x4*)(XG + (size_t)dest * DM) + lane;
#pragma unroll
            for (int j = 0; j < 4; ++j) dst[64 * j] = src[64 * j]; }
        for (int e = 0; e < NE; ++e) { const int r0 = pst[e] + pst[32 + e], r1 = pst[e] + ((pst[32 + e] + 255) & ~255);
            for (int r = r0 + gw; r < r1; r += NGW) { u32x4* dst = (u32x4*)(XG + (size_t)r * DM) + lane;
#pragma unroll
                for (int j = 0; j < 4; ++j) dst[64 * j] = (u32x4){0u, 0u, 0u, 0u}; } }
        __syncthreads();
    }
    SEAM(9);

    if (IN(10)) {
        pg8::Gemm g{DM, DM, DM}; pg8::GroupedOrder S; S.tile_e = TILE + 16; S.ntiles = ld_agent_i(TILE); S.nN = 16; S.G = G; S.c = bx;
        S.A = (const char*)XG; S.B = (const char*)WGU; S.atile = (size_t)256 * DM * 2; S.btile = (size_t)256 * DM * 2; S.bexp = (size_t)4096 * DM * 2;
        pg8::EpiSwiglu E{args.in[I_B_GATE], args.in[I_B_UP], HACT};
        pg8::gemm_phase<pg8::EpiSwiglu, pg8::GroupedOrder>(lds, g, S, E);
    }
    SEAM(10);
    if (IN(11)) {
        pg8::Gemm g{DM, DM, DM}; pg8::GroupedOrder S; S.tile_e = TILE + 16; S.ntiles = ld_agent_i(TILE); S.nN = 8; S.G = G; S.c = bx;
        S.A = (const char*)HACT; S.B = (const char*)WDN; S.atile = (size_t)256 * DM * 2; S.btile = (size_t)256 * DM * 2; S.bexp = (size_t)2048 * DM * 2;
        pg8::EpiDown E{args.in[I_B_DOWN], YY};
        pg8::gemm_phase<pg8::EpiDown, pg8::GroupedOrder>(lds, g, S, E);
    }
    SEAM(11);

    if (IN(12)) {
        const float* gn = args.in[I_PLE_NORM];
        for (int m = gw; m < T; m += NGW) { f32x4* hr = (f32x4*)(H1 + (size_t)m * DM) + lane; f32x4 v[8];
#pragma unroll
            for (int j = 0; j < 8; ++j) v[j] = hr[64 * j];
#pragma unroll
            for (int k = 0; k < 4; ++k) { const int dest = DEST[m * 4 + k]; const float w = AW[m * 4 + k]; const u32x2* yr = (const u32x2*)(YY + (size_t)dest * DM) + lane;
#pragma unroll
                for (int j = 0; j < 8; ++j) { const u32x2 y = yr[64 * j]; v[j][0] += w * bflo(y.x); v[j][1] += w * bfhi(y.x); v[j][2] += w * bflo(y.y); v[j][3] += w * bfhi(y.y); } }
            float s = 0.f;
#pragma unroll
            for (int j = 0; j < 8; ++j) { hr[64 * j] = v[j]; s += (v[j][0] * v[j][0] + v[j][1] * v[j][1]) + (v[j][2] * v[j][2] + v[j][3] * v[j][3]); }
            const float rstd = 1.0f / sqrtf(wave_sum(s) * (1.0f / DM) + EPS);
            u32x2* o8 = (u32x2*)(XN + (size_t)m * DM) + lane;
#pragma unroll
            for (int j = 0; j < 8; ++j) { const f32x4 gv = ((const f32x4*)gn)[64 * j + lane]; u32x2 w; w.x = cvtpk(v[j][0] * rstd * gv[0], v[j][1] * rstd * gv[1]); w.y = cvtpk(v[j][2] * rstd * gv[2], v[j][3] * rstd * gv[3]); o8[64 * j] = w; } }
    }
    SEAM(12);

    if (IN(13)) {
        pg8::Gemm g{256, 256, 256}; pg8::DenseOrder S; S.init(PB, 256, WPLE, 256, T, DM, G, bx);
        pg8::EpiResF32 E{nullptr, EB, DM};
        pg8::gemm_phase<pg8::EpiResF32, pg8::DenseOrder>(lds, g, S, E);
    }
    SEAM(13);
    if (IN(14)) {
        pg8::Gemm g{DM, DM, DM}; pg8::DenseOrder S; S.init(XN, DM, WPG, DM, T, DM, G, bx);
        pg8::EpiPle E{H1, EB, args.out};
        pg8::gemm_phase<pg8::EpiPle, pg8::DenseOrder>(lds, g, S, E);
    }
    SEAM(14);
    if (IN(15)) {
        const float* gn = args.in[I_FINAL_NORM];
        for (int m = gw; m < T; m += NGW) { f32x4* xr = (f32x4*)(args.out + (size_t)m * DM) + lane; f32x4 v[8]; float s = 0.f;
#pragma unroll
            for (int j = 0; j < 8; ++j) { v[j] = xr[64 * j]; s += (v[j][0] * v[j][0] + v[j][1] * v[j][1]) + (v[j][2] * v[j][2] + v[j][3] * v[j][3]); }
            const float rstd = 1.0f / sqrtf(wave_sum(s) * (1.0f / DM) + EPS);
#pragma unroll
            for (int j = 0; j < 8; ++j) { const f32x4 gv = ((const f32x4*)gn)[64 * j + lane]; xr[64 * j] = v[j] * rstd * gv; } }
    }
#undef IN
#undef SEAM
}

extern "C" void kernel_launch(void* const* d_in, const int* in_sizes, int n_in, void* d_out, int out_size, void* d_ws, size_t ws_size, hipStream_t stream) {
    static int grid = 0;
    if (grid == 0) {
        if (n_in != 25 || out_size != T * DM || ws_size < WS_END) { fprintf(stderr, "kernel_launch: unexpected shapes (n_in %d, out %d, ws %zu < %zu)\n", n_in, out_size, ws_size, (size_t)WS_END); grid = -1; return; }
        int dev = 0, cus = 0, per_cu = 0;
        if (hipGetDevice(&dev) != hipSuccess || hipDeviceGetAttribute(&cus, hipDeviceAttributeMultiprocessorCount, dev) != hipSuccess) { grid = -1; return; }
        if (hipFuncSetAttribute((const void*)mega_fwd, hipFuncAttributeMaxDynamicSharedMemorySize, LDS_BYTES) != hipSuccess) { fprintf(stderr, "kernel_launch: hipFuncSetAttribute failed\n"); grid = -1; return; }
        if (hipOccupancyMaxActiveBlocksPerMultiprocessor(&per_cu, (const void*)mega_fwd, 512, LDS_BYTES) != hipSuccess || per_cu < 1) { fprintf(stderr, "kernel_launch: occupancy query says %d blocks per CU\n", per_cu); }
        (void)hipGetLastError();
        grid = cus;
    }
    if (grid < 0) return;
    (void)in_sizes;
    if (hipMemsetAsync((char*)d_ws + WS_CTL, 0, CTL_ZERO_BYTES, stream) != hipSuccess) return;
    Args a{};
    for (int i = 0; i < 25; ++i) a.in[i] = (const float*)d_in[i];
    a.out = (float*)d_out; a.ws = (unsigned char*)d_ws;
    for (int li = 0; li < MK_N_LAUNCHES; ++li) {
        a.ph_lo = (MK_N_LAUNCHES == 1) ? 0 : li; a.ph_hi = (MK_N_LAUNCHES == 1) ? NPHASE : li + 1;
        hipLaunchKernelGGL(mega_fwd, dim3(grid), dim3(512), LDS_BYTES, stream, a);
    }
}
```

```cpp
#include <hip/hip_runtime.h>
#include <cstdio>
#include <cstdint>

#ifndef MK_N_LAUNCHES
#define MK_N_LAUNCHES 1
#endif

#define GAS __attribute__((address_space(1)))
#define LAS __attribute__((address_space(3)))
typedef unsigned short bf16_t;
typedef short bf16x8 __attribute__((ext_vector_type(8)));
typedef short s16x4 __attribute__((ext_vector_type(4)));
typedef float f32x2 __attribute__((ext_vector_type(2)));
typedef float f32x4 __attribute__((ext_vector_type(4)));
typedef float f32x16 __attribute__((ext_vector_type(16)));
typedef unsigned u32x2 __attribute__((ext_vector_type(2)));
typedef unsigned u32x4 __attribute__((ext_vector_type(4)));
typedef int i32x4 __attribute__((ext_vector_type(4)));
typedef int i32x8 __attribute__((ext_vector_type(8)));

constexpr int DM = 2048, NBATCH = 4, SEQ = 4096, T = NBATCH * SEQ;
constexpr int NZ = 8448;
constexpr int ZC_QL = 0, ZC_KVL = 512, ZC_QB = 1024, ZC_KB = 2048, ZC_VB = 3072, ZC_GA = 4096, ZC_GB = 6144, ZC_KR = 8192;
constexpr int NE = 32, TOPK = 4, NA = T * TOPK;
constexpr int PMAX = NA + NE * 256;
constexpr int MAXTILES = PMAX / 256;
constexpr float EPS = 1e-6f;
constexpr int NPHASE = 16;

constexpr size_t MiB = 1u << 20;
constexpr size_t WS_CTL = 0, CTL_ZERO_BYTES = 1 * MiB;
constexpr size_t WS_ROPE = 1 * MiB;
constexpr size_t WS_KM = 2 * MiB;
constexpr size_t WS_TILE = 3 * MiB;
constexpr size_t WS_AE = 4 * MiB, WS_AP = 5 * MiB, WS_AW = 6 * MiB, WS_DEST = 7 * MiB;
constexpr size_t WS_PB = 8 * MiB;
constexpr size_t WS_KR = 16 * MiB;
constexpr size_t WS_WIN = 18 * MiB;
constexpr size_t WS_WUQ = 51 * MiB, WS_WUKV = 53 * MiB, WS_WOA = 55 * MiB, WS_WOB = 59 * MiB, WS_WOUT = 63 * MiB, WS_WPG = 71 * MiB, WS_WPLE = 79 * MiB;
constexpr size_t WS_WGU = 80 * MiB;
constexpr size_t WS_WDN = 336 * MiB;
constexpr size_t WS_H1 = 464 * MiB;
constexpr size_t WS_XN = 592 * MiB;
constexpr size_t WS_R4 = 656 * MiB;
constexpr size_t WS_R1 = 784 * MiB;
constexpr size_t WS_R2 = 1072 * MiB;
constexpr size_t WS_QM = WS_R2, WS_KV = WS_R2 + 48 * MiB, WS_YA = WS_R2 + 112 * MiB, WS_YB = WS_R2 + 144 * MiB, WS_M1 = WS_R2 + 176 * MiB;
constexpr size_t WS_END = 1360 * MiB;
constexpr int CW_TMO = 0;
constexpr int CW_BAR = 4096;
constexpr int CW_CNT = 16384;

constexpr int RING_BYTES = 131072;
constexpr int LDSCTL_OFF = RING_BYTES, MISC_OFF = LDSCTL_OFF + 320;
constexpr int LDS_BYTES = 147456;

#define LDS_WAIT() asm volatile("s_waitcnt lgkmcnt(0)" ::: "memory")
#define VM_WAIT() asm volatile("s_waitcnt vmcnt(0)" ::: "memory")
#define RLX_AGENT __ATOMIC_RELAXED, __HIP_MEMORY_SCOPE_AGENT

__device__ __forceinline__ unsigned cvtpk(float lo, float hi) { unsigned r; asm volatile("v_cvt_pk_bf16_f32 %0, %1, %2" : "=v"(r) : "v"(lo), "v"(hi)); return r; }
__device__ __forceinline__ unsigned cvt4_fp8(float a, float b, float c, float d) { int w = 0; w = __builtin_amdgcn_cvt_pk_fp8_f32(a, b, w, false); w = __builtin_amdgcn_cvt_pk_fp8_f32(c, d, w, true); return (unsigned)w; }
__device__ __forceinline__ float bf2f(unsigned short b) { return __uint_as_float(((unsigned)b) << 16); }
__device__ __forceinline__ float bflo(unsigned w) { return __uint_as_float(w << 16); }
__device__ __forceinline__ float bfhi(unsigned w) { return __uint_as_float(w & 0xffff0000u); }
__device__ __forceinline__ float sigmoidf_(float x) { return __builtin_amdgcn_rcpf(1.0f + __expf(-x)); }
__device__ __forceinline__ float wave_sum(float v) {
#pragma unroll
    for (int o = 1; o < 64; o <<= 1) v += __shfl_xor(v, o);
    return v;
}
__device__ __forceinline__ int ld_agent_i(const int* p) { return __hip_atomic_load(p, RLX_AGENT); }

#define XB_TMO      128
#define XB_XCNT(j)  (256  + 64 * (j))
#define XB_XSUB(j)  (1280 + 64 * (j))
#define XB_XGEN(j)  (2304 + 64 * (j))
#define XB_TOP      3328
#define XB_TOPGEN   3392
#define XCD_BAR_WORDS 3456
#define XB_SPIN_CAP (1u << 22)

__device__ __forceinline__ unsigned xb_ld(unsigned* p)              { return __hip_atomic_load(p, __ATOMIC_RELAXED, __HIP_MEMORY_SCOPE_AGENT); }
__device__ __forceinline__ unsigned xb_add(unsigned* p, unsigned v) { return __hip_atomic_fetch_add(p, v, __ATOMIC_RELAXED, __HIP_MEMORY_SCOPE_AGENT); }
__device__ __forceinline__ unsigned xb_xcc_id() { return (unsigned)__builtin_amdgcn_s_getreg((3 << 11) | 20) & 0xFu; }
#define XB_SPIN(cond, bar) do { unsigned _sp = 0; while (cond) { __builtin_amdgcn_s_sleep(1); \
    if ((++_sp & 255u) == 0u) { if (xb_ld(&(bar)[XB_TMO])) break; if (_sp > XB_SPIN_CAP) { atomicAdd(&(bar)[XB_TMO], 1u); break; } } } } while (0)

struct XcdBarrier { unsigned* bar; unsigned x; volatile LAS unsigned* st; };

__device__ __forceinline__ XcdBarrier xcd_barrier_post(unsigned* bar, volatile LAS unsigned* st) {
    XcdBarrier b; b.bar = bar; b.x = xb_xcc_id(); b.st = st;
    if (threadIdx.x == 0) (void)xb_add(&bar[XB_XCNT(b.x)], 1u);
    return b;
}
__device__ __forceinline__ void xcd_barrier_complete(unsigned* bar, unsigned x, unsigned& nloc, unsigned& nx) {
    const unsigned G = gridDim.x * gridDim.y * gridDim.z;
    unsigned sum, cnt, mine, sp = 0u;
    for (;;) {
        sum = 0u; cnt = 0u; mine = 0u;
#pragma unroll
        for (unsigned j = 0; j < 16; ++j) { const unsigned c = xb_ld(&bar[XB_XCNT(j)]); sum += c; cnt += (c > 0u) ? 1u : 0u; mine = (j == x) ? c : mine; }
        if (sum == G) break;
        __builtin_amdgcn_s_sleep(1);
        if ((++sp & 255u) == 0u) { if (xb_ld(&bar[XB_TMO])) break; if (sp > XB_SPIN_CAP) { atomicAdd(&bar[XB_TMO], 1u); break; } }
    }
    nloc = mine > 0u ? mine : 1u; nx = cnt > 0u ? cnt : 1u;
}
__device__ __forceinline__ void xcd_barrier(const XcdBarrier& b) {
    asm volatile("s_waitcnt vmcnt(0)" ::: "memory");
    __syncthreads();
    if (threadIdx.x == 0) {
        unsigned* bar = b.bar;
        __builtin_amdgcn_s_waitcnt(0);
        unsigned nloc = b.st[0], nx = b.st[1];
        if (nloc == 0u) { xcd_barrier_complete(bar, b.x, nloc, nx); b.st[0] = nloc; b.st[1] = nx; }
        const unsigned old = xb_add(&bar[XB_XSUB(b.x)], 1u);
        const unsigned gen = old / nloc;
        if (old + 1u == (gen + 1u) * nloc) {
            __builtin_amdgcn_fence(__ATOMIC_RELEASE, "agent");
            asm volatile("s_waitcnt vmcnt(0)" ::: "memory");
            const unsigned og = xb_add(&bar[XB_TOP], 1u);
            const unsigned tg = og / nx;
            if (og + 1u == (tg + 1u) * nx) xb_add(&bar[XB_TOPGEN], 1u);
            else XB_SPIN(xb_ld(&bar[XB_TOPGEN]) == tg, bar);
            __builtin_amdgcn_fence(__ATOMIC_ACQUIRE, "agent");
            xb_add(&bar[XB_XGEN(b.x)], 1u);
            asm volatile("s_waitcnt vmcnt(0)" ::: "memory");
        } else {
            XB_SPIN(xb_ld(&bar[XB_XGEN(b.x)]) == gen, bar);
            __builtin_amdgcn_fence(__ATOMIC_ACQUIRE, "agent");
            asm volatile("s_waitcnt vmcnt(0)" ::: "memory");
        }
    }
    __syncthreads();
}

namespace pg8 {
constexpr int BM = 256, BK = 64, HALF = 128, HTB = HALF * BK * 2, STAGE_BYTES = 8 * HTB, NXCD = 8, WGM = 8;
__host__ __device__ __forceinline__ int lds_byte(int r, int c) { const int st = (r >> 4) * 2 + (c >> 5), rr = r & 15, cc = c & 31, ob = rr * 64 + cc * 2; return st * 1024 + (ob ^ (((ob >> 9) & 1) << 5)); }
__host__ __device__ __forceinline__ void stage_rc(int b, int& R, int& C) { const int st = b / 1024, sb = b % 1024, swz = sb ^ (((sb >> 9) & 1) << 5); R = (st >> 1) * 16 + swz / 64; C = (st & 1) * 32 + (swz % 64) / 2; }
__host__ __device__ __forceinline__ int perm32(int rho) { const int n = rho >> 4, i = rho & 15; return 8 * (i >> 2) + 4 * n + (i & 3); }

struct Unit { const char* A; const char* B; int row0, col0, e; };
struct Gemm { int lda, ldb, K; int sa, sb; };

struct DenseOrder {
    int nM, nN, nwg, G, c; const char* A; const char* B; size_t atile, btile;
    __device__ void init(const bf16_t* A_, int lda, const bf16_t* B_, int ldb, int M, int N, int G_, int c_) { nM = M / BM; nN = N / BM; nwg = nM * nN; G = G_; c = c_; A = (const char*)A_; B = (const char*)B_; atile = (size_t)BM * lda; btile = (size_t)BM * ldb; }
    __device__ bool next(int i, Unit& u) const {
        const int L = i * G + c; if (L >= nwg) return false;
        int wgid = L; { const int q = nwg / NXCD, r = nwg % NXCD, xcd = wgid % NXCD, off = wgid / NXCD; wgid = (xcd < r ? xcd * (q + 1) : r * (q + 1) + (xcd - r) * q) + off; }
        const int nig = WGM * nN, gid = wgid / nig, fm = gid * WGM, gsz = (nM - fm) < WGM ? (nM - fm) : WGM;
        const int pm = fm + ((wgid % nig) % gsz), pn = (wgid % nig) / gsz;
        u.row0 = pm * BM; u.col0 = pn * BM; u.e = 0; u.A = A + (size_t)pm * atile; u.B = B + (size_t)pn * btile; return true;
    }
};
struct GroupedOrder {
    const int* tile_e; int ntiles, nN, G, c; const char* A; const char* B; size_t atile, btile, bexp;
    __device__ bool next(int i, Unit& u) const {
        const int L = i * G + c; if (L >= ntiles * nN) return false;
        const int ti = L / nN, pn = L % nN;
        const int e = __builtin_amdgcn_readfirstlane(ld_agent_i(tile_e + ti));
        u.row0 = ti * BM; u.col0 = pn * BM; u.e = e; u.A = A + (size_t)ti * atile; u.B = B + (size_t)e * bexp + (size_t)pn * btile; return true;
    }
};

typedef f32x4 Acc[2][2][4][2];
__device__ __forceinline__ u32x4 pack8(f32x4 a, f32x4 b) { u32x4 w; w.x = cvtpk(a[0], a[1]); w.y = cvtpk(a[2], a[3]); w.z = cvtpk(b[0], b[1]); w.w = cvtpk(b[2], b[3]); return w; }
__device__ __forceinline__ void unpack8(u32x4 w, f32x4& a, f32x4& b) { a = (f32x4){bflo(w.x), bfhi(w.x), bflo(w.y), bfhi(w.y)}; b = (f32x4){bflo(w.z), bfhi(w.z), bflo(w.w), bfhi(w.w)}; }

struct EpiStore {
    static constexpr bool PERM = true; bf16_t* O; int ldc;
    __device__ __forceinline__ void operator()(const Acc& acc, const Unit& u, int wr, int wc, int fr, int fq) const {
        const int row0 = u.row0 + wr * 64 + fr, col0 = u.col0 + wc * 32 + 8 * fq;
#pragma unroll
        for (int ai = 0; ai < 2; ++ai)
#pragma unroll
            for (int m = 0; m < 4; ++m) { bf16_t* rowp = O + (size_t)(row0 + ai * HALF + m * 16) * ldc + col0;
#pragma unroll
                for (int bj = 0; bj < 2; ++bj) *(u32x4*)(rowp + bj * HALF) = pack8(acc[ai][bj][m][0], acc[ai][bj][m][1]); }
    }
};
struct EpiQRope {
    static constexpr bool PERM = true; bf16_t* O; int ldc; const f32x4* rope;
    __device__ __forceinline__ void operator()(const Acc& acc, const Unit& u, int wr, int wc, int fr, int fq) const {
        const int row0 = u.row0 + wr * 64 + fr, col0 = u.col0 + wc * 32 + 8 * fq;
#pragma unroll
        for (int ai = 0; ai < 2; ++ai)
#pragma unroll
            for (int m = 0; m < 4; ++m) { const int row = row0 + ai * HALF + m * 16, pos = row & (SEQ - 1); bf16_t* rowp = O + (size_t)row * ldc + col0;
#pragma unroll
                for (int bj = 0; bj < 2; ++bj) { f32x4 v0 = acc[ai][bj][m][0], v1 = acc[ai][bj][m][1]; const int d = (col0 + bj * HALF) % 192;
                    if (d >= 128) { const int jj = (d - 128) >> 1; const f32x4 c01 = rope[pos * 16 + (jj >> 1)], c23 = rope[pos * 16 + (jj >> 1) + 1];
                        f32x4 w0, w1;
                        w0[0] = v0[0] * c01[0] - v0[1] * c01[1]; w0[1] = v0[0] * c01[1] + v0[1] * c01[0];
                        w0[2] = v0[2] * c01[2] - v0[3] * c01[3]; w0[3] = v0[2] * c01[3] + v0[3] * c01[2];
                        w1[0] = v1[0] * c23[0] - v1[1] * c23[1]; w1[1] = v1[0] * c23[1] + v1[1] * c23[0];
                        w1[2] = v1[2] * c23[2] - v1[3] * c23[3]; w1[3] = v1[2] * c23[3] + v1[3] * c23[2];
                        v0 = w0; v1 = w1; }
                    *(u32x4*)(rowp + bj * HALF) = pack8(v0, v1); } }
    }
};
template <bool HAS_PREV> struct EpiGate {
    static constexpr bool PERM = true; const bf16_t* G; int ldg; const bf16_t* prev; bf16_t* O; int ldc;
    __device__ __forceinline__ void operator()(const Acc& acc, const Unit& u, int wr, int wc, int fr, int fq) const {
        const int row0 = u.row0 + wr * 64 + fr, col0 = u.col0 + wc * 32 + 8 * fq;
#pragma unroll
        for (int ai = 0; ai < 2; ++ai)
#pragma unroll
            for (int m = 0; m < 4; ++m) { const int row = row0 + ai * HALF + m * 16;
#pragma unroll
                for (int bj = 0; bj < 2; ++bj) { const int col = col0 + bj * HALF;
                    f32x4 g0, g1; unpack8(*(const u32x4*)(G + (size_t)row * ldg + col), g0, g1);
                    f32x4 v0 = acc[ai][bj][m][0], v1 = acc[ai][bj][m][1];
#pragma unroll
                    for (int j = 0; j < 4; ++j) { v0[j] *= sigmoidf_(g0[j]); v1[j] *= sigmoidf_(g1[j]); }
                    if (HAS_PREV) { f32x4 p0, p1; unpack8(*(const u32x4*)(prev + (size_t)row * ldc + col), p0, p1); v0 += p0; v1 += p1; }
                    *(u32x4*)(O + (size_t)row * ldc + col) = pack8(v0, v1); } }
    }
};
struct EpiResF32 {
    static constexpr bool PERM = false; const float* base; float* C; int ldc;
    __device__ __forceinline__ void operator()(const Acc& acc, const Unit& u, int wr, int wc, int fr, int fq) const {
        const int row0 = u.row0 + wr * 64 + fr, col0 = u.col0 + wc * 32 + 4 * fq;
#pragma unroll
        for (int ai = 0; ai < 2; ++ai)
#pragma unroll
            for (int m = 0; m < 4; ++m) { const size_t off = (size_t)(row0 + ai * HALF + m * 16) * ldc + col0;
#pragma unroll
                for (int bj = 0; bj < 2; ++bj)
#pragma unroll
                    for (int n = 0; n < 2; ++n) { const f32x4 b = base ? *(const f32x4*)(base + off + bj * HALF + n * 16) : (f32x4){0.f, 0.f, 0.f, 0.f}; *(f32x4*)(C + off + bj * HALF + n * 16) = b + acc[ai][bj][m][n]; } }
    }
};
struct EpiSwiglu {
    static constexpr bool PERM = true; const float* bg; const float* bu; unsigned char* O;
    __device__ __forceinline__ void operator()(const Acc& acc, const Unit& u, int wr, int wc, int fr, int fq) const {
        const int row0 = u.row0 + wr * 64 + fr, hc = (u.col0 >> 1) + wc * 32 + 8 * fq;
        const float* bgp = bg + (size_t)u.e * DM + hc; const float* bup = bu + (size_t)u.e * DM + hc;
        const f32x4 bg0 = *(const f32x4*)bgp, bg1 = *(const f32x4*)(bgp + 4), bu0 = *(const f32x4*)bup, bu1 = *(const f32x4*)(bup + 4);
#pragma unroll
        for (int ai = 0; ai < 2; ++ai)
#pragma unroll
            for (int m = 0; m < 4; ++m) { f32x4 g0 = acc[ai][0][m][0] + bg0, g1 = acc[ai][0][m][1] + bg1, u0 = acc[ai][1][m][0] + bu0, u1 = acc[ai][1][m][1] + bu1, r0, r1;
#pragma unroll
                for (int j = 0; j < 4; ++j) {
                    const float ga = fminf(g0[j], 7.0f), gb = fminf(g1[j], 7.0f);
                    const float ua = fminf(fmaxf(u0[j], -7.0f), 7.0f), ub = fminf(fmaxf(u1[j], -7.0f), 7.0f);
                    r0[j] = ga * sigmoidf_(1.702f * ga) * (ua + 1.0f); r1[j] = gb * sigmoidf_(1.702f * gb) * (ub + 1.0f); }
                u32x2 w; w.x = cvt4_fp8(r0[0], r0[1], r0[2], r0[3]); w.y = cvt4_fp8(r1[0], r1[1], r1[2], r1[3]);
                *(u32x2*)(O + (size_t)(row0 + ai * HALF + m * 16) * DM + hc) = w; }
    }
};
struct EpiDown {
    static constexpr bool PERM = true; const float* bd; bf16_t* O;
    __device__ __forceinline__ void operator()(const Acc& acc, const Unit& u, int wr, int wc, int fr, int fq) const {
        const int row0 = u.row0 + wr * 64 + fr, col0 = u.col0 + wc * 32 + 8 * fq;
        const float* bp = bd + (size_t)u.e * DM + col0;
        f32x4 bv[2][2];
#pragma unroll
        for (int bj = 0; bj < 2; ++bj) { bv[bj][0] = *(const f32x4*)(bp + bj * HALF); bv[bj][1] = *(const f32x4*)(bp + bj * HALF + 4); }
#pragma unroll
        for (int ai = 0; ai < 2; ++ai)
#pragma unroll
            for (int m = 0; m < 4; ++m) { bf16_t* rowp = O + (size_t)(row0 + ai * HALF + m * 16) * DM + col0;
#pragma unroll
                for (int bj = 0; bj < 2; ++bj) *(u32x4*)(rowp + bj * HALF) = pack8(acc[ai][bj][m][0] + bv[bj][0], acc[ai][bj][m][1] + bv[bj][1]); }
    }
};
struct EpiPle {
    static constexpr bool PERM = false; const float* h; const float* emb; float* out;
    __device__ __forceinline__ void operator()(const Acc& acc, const Unit& u, int wr, int wc, int fr, int fq) const {
        const int row0 = u.row0 + wr * 64 + fr, col0 = u.col0 + wc * 32 + 4 * fq;
#pragma unroll
        for (int ai = 0; ai < 2; ++ai)
#pragma unroll
            for (int m = 0; m < 4; ++m) { const size_t off = (size_t)(row0 + ai * HALF + m * 16) * DM + col0;
#pragma unroll
                for (int bj = 0; bj < 2; ++bj)
#pragma unroll
                    for (int n = 0; n < 2; ++n) { const size_t o = off + bj * HALF + n * 16; const f32x4 hv = *(const f32x4*)(h + o), ev = *(const f32x4*)(emb + o); f32x4 a = acc[ai][bj][m][n], r;
#pragma unroll
                        for (int j = 0; j < 4; ++j) r[j] = hv[j] + ev[j] * sigmoidf_(a[j]);
                        *(f32x4*)(out + o) = r; } }
    }
};

template <class Epi, class Sched, bool F8 = false>
__device__ __forceinline__ void gemm_phase(LAS unsigned char* lds, const Gemm g, const Sched& S, const Epi& E) {
    const int tid = threadIdx.x, wid = __builtin_amdgcn_readfirstlane(tid >> 6), lane = tid & 63, wr = wid >> 2, wc = wid & 3, fr = lane & 15, fq = lane >> 4;
    const int nt = g.K / (BK * 2);
    unsigned voffA[2], voffB[2];
#pragma unroll
    for (int i = 0; i < 2; ++i) { int R, C; stage_rc(tid * 16 + i * 8192, R, C); const int Rb = Epi::PERM ? ((R & ~31) + perm32(R & 31)) : R;
        voffA[i] = (unsigned)(R * g.lda + C * 2); voffB[i] = (unsigned)(Rb * g.ldb + C * 2); }
    const size_t kstep = (size_t)(BK * 2);
    const size_t hstepA = (size_t)HALF * g.lda, hstepB = (size_t)HALF * g.ldb;
    const unsigned ldsw = (unsigned)wid * 1024u, ldsb = (unsigned)(uintptr_t)lds;
    const int aoff = lds_byte(wr * 64 + fr, fq * 8), boff = lds_byte(wc * 32 + fr, fq * 8);
#define PG8_SA(b, h) (((b) * 2 + (h)) * HTB)
#define PG8_SB(b, h) ((4 + (b) * 2 + (h)) * HTB)
#define PG8_STAGE(bufoff, gbase, voff) do { _Pragma("unroll") for (int _i = 0; _i < 2; ++_i) \
        asm volatile("s_mov_b32 m0, %0\n\ts_nop 0\n\tglobal_load_lds_dwordx4 %1, %2" :: "s"(ldsb + (unsigned)(bufoff) + ldsw + _i * 8192u), "v"((voff)[_i]), "s"((const char*)(gbase)) : "m0", "memory"); } while (0)
#define PG8_LDA(dst, b, h) do { _Pragma("unroll") for (int m = 0; m < 4; ++m) { \
        if constexpr (F8) dst##8[m] = __builtin_shufflevector(*(const LAS i32x4*)(lds + PG8_SA(b, h) + aoff + m * 2048), *(const LAS i32x4*)(lds + PG8_SA(b, h) + aoff + m * 2048 + 1024), 0, 1, 2, 3, 4, 5, 6, 7); \
        else { _Pragma("unroll") for (int k = 0; k < 2; ++k) dst[m][k] = *(const LAS bf16x8*)(lds + PG8_SA(b, h) + aoff + m * 2048 + k * 1024); } } } while (0)
#define PG8_LDB(dst, b, h) do { _Pragma("unroll") for (int n = 0; n < 2; ++n) { \
        if constexpr (F8) dst##8[n] = __builtin_shufflevector(*(const LAS i32x4*)(lds + PG8_SB(b, h) + boff + n * 2048), *(const LAS i32x4*)(lds + PG8_SB(b, h) + boff + n * 2048 + 1024), 0, 1, 2, 3, 4, 5, 6, 7); \
        else { _Pragma("unroll") for (int k = 0; k < 2; ++k) dst[n][k] = *(const LAS bf16x8*)(lds + PG8_SB(b, h) + boff + n * 2048 + k * 1024); } } } while (0)
#define PG8_MMA(ai, bj, At, Bt) do { __builtin_amdgcn_s_setprio(1); _Pragma("unroll") for (int m = 0; m < 4; ++m) _Pragma("unroll") for (int n = 0; n < 2; ++n) { \
        if constexpr (F8) { asm volatile("v_mfma_scale_f32_16x16x128_f8f6f4 %0, %1, %2, %0, %3, %4 op_sel_hi:[0,0,0]" : "+v"(acc[ai][bj][m][n]) : "v"(Bt##8[n]), "v"(At##8[m]), "v"(g.sb), "v"(g.sa)); } \
        else { _Pragma("unroll") for (int k = 0; k < 2; ++k) acc[ai][bj][m][n] = __builtin_amdgcn_mfma_f32_16x16x32_bf16(Bt[n][k], At[m][k], acc[ai][bj][m][n], 0, 0, 0); } } \
        __builtin_amdgcn_s_setprio(0); } while (0)
#define PG8_WAIT_V(n) asm volatile("s_waitcnt vmcnt(" #n ")" ::: "memory")
#define PG8_WAIT_L(n) asm volatile("s_waitcnt lgkmcnt(" #n ")" ::: "memory")
#define PG8_BAR __builtin_amdgcn_s_barrier()
#define PG8_SCHED __builtin_amdgcn_sched_barrier(0)
    Unit cur, nxt; int ui = 0;
    if (!S.next(0, cur)) return;
    f32x4 acc[2][2][4][2];
#pragma unroll
    for (int a = 0; a < 2; ++a)
#pragma unroll
        for (int b = 0; b < 2; ++b)
#pragma unroll
            for (int m = 0; m < 4; ++m)
#pragma unroll
                for (int n = 0; n < 2; ++n) acc[a][b][m][n] = (f32x4){0.f, 0.f, 0.f, 0.f};
    bf16x8 At[4][2], B0[2][2], B1[2][2]; i32x8 At8[4], B08[2], B18[2];
    const char* cA = cur.A; const char* cB = cur.B;
    PG8_STAGE(PG8_SB(0, 0), cB, voffB); PG8_STAGE(PG8_SB(0, 1), cB + hstepB, voffB); PG8_STAGE(PG8_SA(0, 0), cA, voffA); PG8_STAGE(PG8_SA(0, 1), cA + hstepA, voffA);
    if (wr == 1) PG8_BAR;
    PG8_WAIT_V(2); PG8_BAR;
    PG8_STAGE(PG8_SB(1, 0), cB + kstep, voffB); PG8_STAGE(PG8_SA(1, 0), cA + kstep, voffA); PG8_STAGE(PG8_SB(1, 1), cB + hstepB + kstep, voffB);
    PG8_WAIT_V(6); PG8_BAR;
    for (;;) {
        const bool has_next = S.next(ui + 1, nxt);
        const char* nA = has_next ? nxt.A : cA; const char* nB = has_next ? nxt.B : cB;
        for (int t = 0; t < nt; t += 2) {
            const bool last = (t == nt - 2);
            const char* a1 = cA + (size_t)(t + 1) * kstep;
            const char* a2 = last ? nA : cA + (size_t)(t + 2) * kstep; const char* b2 = last ? nB : cB + (size_t)(t + 2) * kstep;
            const char* a3 = a2 + kstep; const char* b3 = b2 + kstep;
            PG8_LDB(B0, 0, 0); PG8_LDB(B1, 0, 1); PG8_SCHED; PG8_LDA(At, 0, 0); PG8_STAGE(PG8_SA(1, 1), a1 + hstepA, voffA);
            PG8_WAIT_V(8); PG8_WAIT_L(0); PG8_BAR; PG8_MMA(0, 0, At, B0); PG8_MMA(0, 1, At, B1); PG8_BAR; PG8_SCHED;
            PG8_LDA(At, 0, 1); PG8_STAGE(PG8_SB(0, 0), b2, voffB); PG8_STAGE(PG8_SB(0, 1), b2 + hstepB, voffB); PG8_STAGE(PG8_SA(0, 0), a2, voffA);
            PG8_WAIT_V(8); PG8_WAIT_L(0); PG8_BAR; PG8_MMA(1, 0, At, B0); PG8_MMA(1, 1, At, B1); PG8_BAR; PG8_SCHED;
            PG8_LDB(B0, 1, 0); PG8_LDB(B1, 1, 1); PG8_SCHED; PG8_LDA(At, 1, 0); PG8_STAGE(PG8_SA(0, 1), a2 + hstepA, voffA);
            PG8_WAIT_V(8); PG8_WAIT_L(0); PG8_BAR; PG8_MMA(0, 0, At, B0); PG8_MMA(0, 1, At, B1); PG8_BAR; PG8_SCHED;
            PG8_LDA(At, 1, 1); PG8_STAGE(PG8_SB(1, 0), b3, voffB); PG8_STAGE(PG8_SB(1, 1), b3 + hstepB, voffB); PG8_STAGE(PG8_SA(1, 0), a3, voffA);
            PG8_WAIT_V(8); PG8_WAIT_L(0); PG8_BAR; PG8_MMA(1, 0, At, B0); PG8_MMA(1, 1, At, B1); PG8_BAR; PG8_SCHED;
        }
        if (wr == 0) PG8_BAR;
        if constexpr (F8) asm volatile("s_nop 15\n\ts_nop 15" ::: "memory");
        { int l_; asm volatile("v_mbcnt_lo_u32_b32 %0, -1, 0\n\tv_mbcnt_hi_u32_b32 %0, -1, %0" : "=v"(l_)); E(acc, cur, wr, wc, l_ & 15, l_ >> 4); }
        if (!has_next) break;
#pragma unroll
        for (int a = 0; a < 2; ++a)
#pragma unroll
            for (int b = 0; b < 2; ++b)
#pragma unroll
                for (int m = 0; m < 4; ++m)
#pragma unroll
                    for (int n = 0; n < 2; ++n) acc[a][b][m][n] = (f32x4){0.f, 0.f, 0.f, 0.f};
        cur = nxt; cA = nA; cB = nB; ++ui;
        if (wr == 1) PG8_BAR;
    }
    PG8_WAIT_V(0);
    PG8_BAR;
#undef PG8_SA
#undef PG8_SB
#undef PG8_STAGE
#undef PG8_LDA
#undef PG8_LDB
#undef PG8_MMA
#undef PG8_WAIT_V
#undef PG8_WAIT_L
#undef PG8_BAR
#undef PG8_SCHED
}
}

namespace att {
constexpr int SHM_V = 64 * 128 * 2, SHM_KN = 64 * 128 * 2, SHM_KR = 64 * 64 * 2;
constexpr int OFF_KN = 2 * SHM_V, OFF_KR = OFF_KN + 2 * SHM_KN, OFF_WS = OFF_KR + 2 * SHM_KR, OFF_SEL = OFF_WS + 8 * 64 * 4, OFF_BT = OFF_SEL + 1024, OFF_KM = OFF_BT + 1024, ATT_LDS = OFF_KM + 8192;
static_assert(ATT_LDS <= RING_BYTES, "attention LDS");
__device__ __forceinline__ int v_rd_base(int lane) { return ((lane & 3) << 3) | (((lane >> 2) & 3) << 6) | (((lane >> 4) & 1) << 5) | (((lane >> 5) & 1) << 8); }
__device__ __forceinline__ int crow(int r, int hi) { return (r & 3) + 8 * (r >> 2) + 4 * hi; }
#define CROWC(r) (((r) & 3) + 8 * ((r) >> 2))
#define SBAR() __builtin_amdgcn_sched_barrier(0)

template <bool MLA>
__device__ __forceinline__ void attn_unit(char* lds, int h, int qb, const bf16_t* Qp, int ldq, const bf16_t* Kp, int ldk, const bf16_t* KRp, const bf16_t* Vp, int ldv,
                                          bf16_t* Op, int ldo, const float* KMp, const float* rel_bias) {
    constexpr int DK = MLA ? 192 : 128, NQ = DK / 16;
    constexpr float SCALE = MLA ? 0.07216878364870323f : 0.08838834764831845f;
    constexpr float C2 = 1.4426950408889634f * SCALE, THR = 8.f;
    const float NEG = -__builtin_inff();
    const int tid = threadIdx.x, wid = __builtin_amdgcn_readfirstlane(tid >> 6), lane = tid & 63, r32 = lane & 31, hi = lane >> 5;
    float* wsf = (float*)(lds + OFF_WS) + wid * 64; float* li_l = wsf; float* al_l = wsf + 32; const float* al_h = al_l + 4 * hi; const float* li_h = li_l + 4 * hi;
    unsigned* sel_l = (unsigned*)(lds + OFF_SEL); float* bt_l = (float*)(lds + OFF_BT); float* km_l = (float*)(lds + OFF_KM);
    const int q0 = qb * 256, qlo = q0 + wid * 32, qpos = qlo + r32, NT = (qb + 1) * 4;
    unsigned offKn[2], offV[2], offKr;
#pragma unroll
    for (int i = 0; i < 2; ++i) { const int pc = wid * 2 + i;
        { const int row = pc * 4 + (lane >> 4), colB = ((lane & 15) * 16) ^ ((row & 7) << 4); offKn[i] = (unsigned)(row * ldk + (colB >> 1)); }
        { const int sub = pc * 2 + (lane >> 5), kk = (sub >> 2) * 8 + ((lane & 31) >> 2), c = (sub & 3) * 32 + (lane & 3) * 8; const int k = (kk & ~0xC) | ((kk & 4) << 1) | ((kk & 8) >> 1);
          offV[i] = (unsigned)(k * ldv + c); } }
    { const int row = wid * 8 + (lane >> 3), colB = ((lane & 7) * 16) ^ ((row & 7) << 4); offKr = (unsigned)(row * 64 + (colB >> 1)); }
#define A_ISSUE(kb, buf) do { \
        _Pragma("unroll") for (int i_ = 0; i_ < 2; ++i_) { \
            __builtin_amdgcn_global_load_lds((const unsigned*)(Kp + (size_t)(kb) * ldk + offKn[i_]), (LAS unsigned*)(lds + OFF_KN + (buf) * SHM_KN + (wid * 2 + i_) * 1024), 16, 0, 0); \
            __builtin_amdgcn_global_load_lds((const unsigned*)(Vp + (size_t)(kb) * ldv + offV[i_]), (LAS unsigned*)(lds + (buf) * SHM_V + (wid * 2 + i_) * 1024), 16, 0, 0); } \
        if constexpr (MLA) __builtin_amdgcn_global_load_lds((const unsigned*)(KRp + (size_t)(kb) * 64 + offKr), (LAS unsigned*)(lds + OFF_KR + (buf) * SHM_KR + wid * 1024), 16, 0, 0); } while (0)
    A_ISSUE(0, 0);
    bf16x8 qr[NQ];
    { const bf16_t* qrow = Qp + (size_t)qpos * ldq;
#pragma unroll
      for (int d0 = 0; d0 < NQ; ++d0) qr[d0] = *(const bf16x8*)(qrow + d0 * 16 + hi * 8); }
    unsigned mysel = 0u;
    if constexpr (!MLA) {
        if (tid <= 128) { const int n = tid; int bk; if (n < 16) bk = n; else { const float v = logf((float)n * (1.0f / 16.0f)) / logf(8.0f) * 16.0f; bk = 16 + (int)v; if (bk > 31) bk = 31; }
            bt_l[tid] = rel_bias[bk * 8 + h] * (1.0f / SCALE); }
        for (int i = tid; i < 16 * 128; i += 512) km_l[i] = KMp[i];
        __syncthreads();
        { const int row = tid >> 1, half = tid & 1;
          unsigned mask;
          if (qb <= 3) mask = (1u << qb) - 1u;
          else { const bf16_t* qrow = Qp + (size_t)(q0 + row) * ldq + half * 64;
              u32x4 qv[8];
#pragma unroll
              for (int c = 0; c < 8; ++c) qv[c] = *(const u32x4*)(qrow + c * 8);
              float v0 = NEG, v1 = NEG, v2 = NEG; int i0 = 0, i1 = 0, i2 = 0;
#pragma unroll 1
              for (int n = 0; n < qb; ++n) { const float* kp = km_l + n * 128 + half * 64; float x = 0.f;
#pragma unroll
                  for (int c = 0; c < 8; ++c) { const f32x4 k0 = *(const f32x4*)(kp + c * 8), k1 = *(const f32x4*)(kp + c * 8 + 4);
                      x += bflo(qv[c].x) * k0[0] + bfhi(qv[c].x) * k0[1] + bflo(qv[c].y) * k0[2] + bfhi(qv[c].y) * k0[3] + bflo(qv[c].z) * k1[0] + bfhi(qv[c].z) * k1[1] + bflo(qv[c].w) * k1[2] + bfhi(qv[c].w) * k1[3]; }
                  x += __shfl_xor(x, 1);
                  if (x > v0) { v2 = v1; i2 = i1; v1 = v0; i1 = i0; v0 = x; i0 = n; } else if (x > v1) { v2 = v1; i2 = i1; v1 = x; i1 = n; } else if (x > v2) { v2 = x; i2 = n; } }
              mask = (1u << i0) | (1u << i1) | (1u << i2); }
          if (half == 0) sel_l[row] = mask; }
        __syncthreads();
        mysel = sel_l[wid * 32 + r32];
    }
    float m_reg = -1e30f, l_reg = 0.f; f32x16 o[4];
#pragma unroll
    for (int d = 0; d < 4; ++d)
#pragma unroll
        for (int r = 0; r < 16; ++r) o[d][r] = 0.f;
    int kan[4], kar[4];
#pragma unroll
    for (int dd = 0; dd < 4; ++dd) { kan[dd] = OFF_KN + r32 * 256 + ((dd * 32 + hi * 16) ^ ((r32 & 7) << 4)); kar[dd] = OFF_KR + r32 * 128 + ((dd * 32 + hi * 16) ^ ((r32 & 7) << 4)); }
    const int vrb = (int)(uintptr_t)lds + v_rd_base(lane);
    VM_WAIT(); __syncthreads();
    for (int t = 0; t < NT; ++t) {
        const int buf = t & 1, kb = t * 64, jb = kb >> 8;
        if (t + 1 < NT) A_ISSUE(kb + 64, buf ^ 1);
        int act;
        if (MLA || jb == qb) act = (kb <= qlo + 31) ? 1 : 0; else act = __any((int)((mysel >> jb) & 1u)) ? 1 : 0;
        act = __builtin_amdgcn_readfirstlane(act);
        if (act) {
            f32x16 p0, p1;
#pragma unroll
            for (int r = 0; r < 16; ++r) { p0[r] = 0.f; p1[r] = 0.f; }
            { const char* kn = lds + buf * SHM_KN; const char* kr = lds + buf * SHM_KR;
#pragma unroll
              for (int d0 = 0; d0 < 8; ++d0) { const char* ap = kn + kan[d0 & 3] + (d0 >> 2) * 128;
                  const bf16x8 a0 = *(const bf16x8*)ap, a1 = *(const bf16x8*)(ap + 32 * 256);
                  p0 = __builtin_amdgcn_mfma_f32_32x32x16_bf16(a0, qr[d0], p0, 0, 0, 0);
                  p1 = __builtin_amdgcn_mfma_f32_32x32x16_bf16(a1, qr[d0], p1, 0, 0, 0); }
              if constexpr (MLA) {
#pragma unroll
                  for (int d0 = 8; d0 < 12; ++d0) { const char* ap = kr + kar[d0 & 3];
                      const bf16x8 a0 = *(const bf16x8*)ap, a1 = *(const bf16x8*)(ap + 32 * 128);
                      p0 = __builtin_amdgcn_mfma_f32_32x32x16_bf16(a0, qr[d0], p0, 0, 0, 0);
                      p1 = __builtin_amdgcn_mfma_f32_32x32x16_bf16(a1, qr[d0], p1, 0, 0, 0); } } }
            const int dq = qpos - kb - 4 * hi;
            if constexpr (MLA) {
                if (kb + 63 > qlo) {
#pragma unroll
                    for (int r = 0; r < 16; ++r) { const int d0 = dq - CROWC(r); if (d0 < 0) p0[r] = NEG; if (d0 < 32) p1[r] = NEG; } }
            } else {
                const bool selq = (jb == qb) || (((mysel >> jb) & 1u) != 0u);
                if (q0 - (kb + 63) >= 128) { const float cb = bt_l[128];
#pragma unroll
                    for (int r = 0; r < 16; ++r) { p0[r] = selq ? p0[r] + cb : NEG; p1[r] = selq ? p1[r] + cb : NEG; } }
                else {
#pragma unroll
                    for (int r4 = 0; r4 < 4; ++r4) {
#pragma unroll
                        for (int rr = 0; rr < 4; ++rr) { const int r = r4 * 4 + rr; const int d0 = dq - CROWC(r), d1 = d0 - 32;
                            const float b0 = bt_l[d0 < 0 ? 0 : (d0 > 128 ? 128 : d0)], b1 = bt_l[d1 < 0 ? 0 : (d1 > 128 ? 128 : d1)];
                            p0[r] = (selq && d0 >= 0) ? p0[r] + b0 : NEG; p1[r] = (selq && d1 >= 0) ? p1[r] + b1 : NEG; }
                        SBAR(); } }
            }
            float pmax = p0[0];
#pragma unroll
            for (int r = 1; r < 16; ++r) pmax = fmaxf(pmax, p0[r]);
#pragma unroll
            for (int r = 0; r < 16; ++r) pmax = fmaxf(pmax, p1[r]);
            { auto rr = __builtin_amdgcn_permlane32_swap(__float_as_uint(pmax), __float_as_uint(pmax), false, false); pmax = fmaxf(__uint_as_float(rr[0]), __uint_as_float(rr[1])); }
            float mn, alpha;
            if (__all((pmax - m_reg) * SCALE <= THR)) { mn = m_reg; alpha = 1.f; }
            else { mn = fmaxf(m_reg, pmax); alpha = __builtin_amdgcn_exp2f((m_reg - mn) * C2); m_reg = mn; }
            const float mnL = -mn * C2;
#pragma unroll
            for (int r = 0; r < 16; ++r) { p0[r] = __builtin_amdgcn_exp2f(fmaf(p0[r], C2, mnL)); p1[r] = __builtin_amdgcn_exp2f(fmaf(p1[r], C2, mnL)); }
            float ps = 0.f;
#pragma unroll
            for (int r = 0; r < 16; ++r) ps += p0[r];
#pragma unroll
            for (int r = 0; r < 16; ++r) ps += p1[r];
            { auto rr = __builtin_amdgcn_permlane32_swap(__float_as_uint(ps), __float_as_uint(ps), false, false); ps = __uint_as_float(rr[0]) + __uint_as_float(rr[1]); }
            l_reg = l_reg * alpha + ps;
            bf16x8 pa0, pa1, pa2, pa3;
#define PK4(P, B_, OUT) do { unsigned a0_ = cvtpk(P[B_ + 0], P[B_ + 1]), a1_ = cvtpk(P[B_ + 2], P[B_ + 3]); unsigned b0_ = cvtpk(P[B_ + 4], P[B_ + 5]), b1_ = cvtpk(P[B_ + 6], P[B_ + 7]); \
            auto r0_ = __builtin_amdgcn_permlane32_swap(a0_, b0_, false, false); auto r1_ = __builtin_amdgcn_permlane32_swap(a1_, b1_, false, false); \
            u32x4 w_ = {r0_[0], r1_[0], r0_[1], r1_[1]}; OUT = *reinterpret_cast<bf16x8*>(&w_); } while (0)
            PK4(p0, 0, pa0); PK4(p0, 8, pa1); PK4(p1, 0, pa2); PK4(p1, 8, pa3);
#undef PK4
            if (__any(alpha < 1.f)) { if (hi == 0) al_l[r32] = alpha; LDS_WAIT();
#pragma unroll
                for (int r = 0; r < 16; ++r) { const float a = al_h[CROWC(r)];
#pragma unroll
                    for (int d_ = 0; d_ < 4; ++d_) o[d_][r] *= a; } }
            { const int vb0 = vrb + buf * SHM_V;
#define TRRD(dst, off) asm volatile("ds_read_b64_tr_b16 %0, %1 offset:%2" : "=&v"(dst) : "v"(vb0), "i"(off) : "memory")
#define PV_D0(d0) do { s16x4 l0, l1, l2, l3, h0, h1, h2, h3; constexpr int b_ = (d0) * 512; \
            TRRD(l0, b_); TRRD(h0, b_ + 2048); TRRD(l1, b_ + 4096); TRRD(h1, b_ + 6144); TRRD(l2, b_ + 8192); TRRD(h2, b_ + 10240); TRRD(l3, b_ + 12288); TRRD(h3, b_ + 14336); \
            asm volatile("s_waitcnt lgkmcnt(0)" ::: "memory"); SBAR(); \
            o[d0] = __builtin_amdgcn_mfma_f32_32x32x16_bf16(pa0, (bf16x8){l0[0], l0[1], l0[2], l0[3], h0[0], h0[1], h0[2], h0[3]}, o[d0], 0, 0, 0); \
            o[d0] = __builtin_amdgcn_mfma_f32_32x32x16_bf16(pa1, (bf16x8){l1[0], l1[1], l1[2], l1[3], h1[0], h1[1], h1[2], h1[3]}, o[d0], 0, 0, 0); \
            o[d0] = __builtin_amdgcn_mfma_f32_32x32x16_bf16(pa2, (bf16x8){l2[0], l2[1], l2[2], l2[3], h2[0], h2[1], h2[2], h2[3]}, o[d0], 0, 0, 0); \
            o[d0] = __builtin_amdgcn_mfma_f32_32x32x16_bf16(pa3, (bf16x8){l3[0], l3[1], l3[2], l3[3], h3[0], h3[1], h3[2], h3[3]}, o[d0], 0, 0, 0); SBAR(); } while (0)
              PV_D0(0); PV_D0(1); PV_D0(2); PV_D0(3);
#undef PV_D0
#undef TRRD
            }
        }
        VM_WAIT();
        __syncthreads();
    }
#undef A_ISSUE
    if (hi == 0) li_l[r32] = l_reg; LDS_WAIT();
    bf16_t* Ow = Op + (size_t)qlo * ldo;
#pragma unroll
    for (int r = 0; r < 16; ++r) { const int orow = CROWC(r) + 4 * hi; const float rl = __builtin_amdgcn_rcpf(li_h[CROWC(r)]);
#pragma unroll
        for (int d0 = 0; d0 < 4; ++d0) { const float v = o[d0][r] * rl; const float vn = __shfl_xor(v, 1);
            if ((r32 & 1) == 0) *(unsigned*)(Ow + (size_t)orow * ldo + d0 * 32 + r32) = cvtpk(v, vn); } }
    __syncthreads();
}
}

struct Args { const float* in[25]; float* out; unsigned char* ws; int ph_lo, ph_hi; };
enum { I_X = 0, I_P, I_ATTN_NORM, I_W_IN, I_QLN, I_KVLN, I_W_UQ, I_W_UKV, I_W_O_MLA, I_W_O_MOBA, I_W_OUT, I_REL_BIAS, I_MOE_NORM, I_W_ROUTER, I_B_ROUTER,
       I_W_GATE, I_B_GATE, I_W_UP, I_B_UP, I_W_DOWN, I_B_DOWN, I_PLE_NORM, I_W_PLE_GATE, I_W_PLE, I_FINAL_NORM };

__device__ const double ROPE_REV[32] = {
    1.59154943091895345608e-01, 1.19349370211248861917e-01, 8.94994016088910132600e-02, 6.71150830052272551196e-02, 5.03292121044870352509e-02, 3.77415847174197710556e-02, 2.83021958306233986646e-02, 2.12236527647776604399e-02,
    1.59154943091895338669e-02, 1.19349370211248861917e-02, 8.94994016088910236684e-03, 6.71150830052272533849e-03, 5.03292121044870369856e-03, 3.77415847174197719230e-03, 2.83021958306233986646e-03, 2.12236527647776621747e-03,
    1.59154943091895334333e-03, 1.19349370211248848907e-03, 8.94994016088910128263e-04, 6.71150830052272490481e-04, 5.03292121044870326488e-04, 3.77415847174197686704e-04, 2.83021958306233954120e-04, 2.12236527647776605484e-04,
    1.59154943091895323490e-04, 1.19349370211248848907e-04, 8.94994016088910182474e-05, 6.71150830052272544691e-05, 5.03292121044870353593e-05, 3.77415847174197700256e-05, 2.83021958306233960897e-05, 2.12236527647776591931e-05};

template <int MODE> __device__ __forceinline__ int map_row(int n) {
    if (MODE == 1) return n < 1024 ? n : (n < 1088 ? 8192 + (n - 1024) : n - 64);
    if (MODE == 2) { const int hh = n / 192, d = n % 192; if (d < 128) return n; const int i = d - 128; return hh * 192 + 128 + 2 * (i & 31) + (i >> 5); }
    if (MODE == 3) return (n >> 7) * 256 + (n & 127);
    if (MODE == 4) return (n >> 7) * 256 + 128 + (n & 127);
    return n;
}
template <int MODE> __device__ __forceinline__ void tr_item(const float* W, int ldw, int K, int k0, int n0, bf16_t* WT, LAS float* scr, int lane) {
#pragma unroll
    for (int i = 0; i < 8; ++i) { const int kk = i * 8 + (lane >> 3); const f32x4 v = *(const GAS f32x4*)(W + (size_t)(k0 + kk) * ldw + n0 + (lane & 7) * 4);
        LAS float* s = scr + kk * 33 + (lane & 7) * 4; s[0] = v[0]; s[1] = v[1]; s[2] = v[2]; s[3] = v[3]; }
    LDS_WAIT(); asm volatile("" ::: "memory");
    const int c = lane & 7;
#pragma unroll
    for (int j = 0; j < 4; ++j) { const int n = (lane >> 3) + 8 * j; const LAS float* s = scr + (8 * c) * 33 + n;
        u32x4 o; o.x = cvtpk(s[0 * 33], s[1 * 33]); o.y = cvtpk(s[2 * 33], s[3 * 33]); o.z = cvtpk(s[4 * 33], s[5 * 33]); o.w = cvtpk(s[6 * 33], s[7 * 33]);
        *(GAS u32x4*)(WT + (size_t)map_row<MODE>(n0 + n) * K + k0 + 8 * c) = o; }
    LDS_WAIT(); asm volatile("" ::: "memory");
}
template <int MODE> __device__ __forceinline__ void tr_mat8(const float* W, int K, int N, unsigned char* WT, LAS float* scr, int lane, int item) {
    const int nblk = N / 32, kb = item / nblk, nb = item % nblk, k0 = kb * 64, n0 = nb * 32;
#pragma unroll
    for (int i = 0; i < 8; ++i) { const int kk = i * 8 + (lane >> 3); const f32x4 v = *(const GAS f32x4*)(W + (size_t)(k0 + kk) * N + n0 + (lane & 7) * 4);
        LAS float* s = scr + kk * 33 + (lane & 7) * 4; s[0] = v[0]; s[1] = v[1]; s[2] = v[2]; s[3] = v[3]; }
    LDS_WAIT(); asm volatile("" ::: "memory");
    const int c = lane & 7;
#pragma unroll
    for (int j = 0; j < 4; ++j) { const int n = (lane >> 3) + 8 * j; const LAS float* s = scr + (8 * c) * 33 + n;
        u32x2 o; o.x = cvt4_fp8(s[0 * 33] * 64.f, s[1 * 33] * 64.f, s[2 * 33] * 64.f, s[3 * 33] * 64.f); o.y = cvt4_fp8(s[4 * 33] * 64.f, s[5 * 33] * 64.f, s[6 * 33] * 64.f, s[7 * 33] * 64.f);
        *(GAS u32x2*)(WT + (size_t)map_row<MODE>(n0 + n) * K + k0 + 8 * c) = o; }
    LDS_WAIT(); asm volatile("" ::: "memory");
}
template <int MODE> __device__ __forceinline__ void tr_mat(const float* W, int K, int N, bf16_t* WT, LAS float* scr, int lane, int item) {
    const int nblk = N / 32, kb = item / nblk, nb = item % nblk;
    tr_item<MODE>(W, N, K, kb * 64, nb * 32, WT, scr, lane);
}

__global__ void __launch_bounds__(512, 2) mega_fwd(Args args) {
    extern __shared__ __attribute__((aligned(16))) unsigned char lds_raw[];
    LAS unsigned char* lds = (LAS unsigned char*)lds_raw;
    volatile LAS unsigned* MISC = (volatile LAS unsigned*)(lds + MISC_OFF);
    const int tid = threadIdx.x, lane = tid & 63, wave = __builtin_amdgcn_readfirstlane(tid >> 6);
    const int G = gridDim.x, bx = blockIdx.x;
    unsigned char* ws = args.ws;
    unsigned* ctl = (unsigned*)(ws + WS_CTL);
    for (int u = tid; u < (LDS_BYTES - LDSCTL_OFF) / 4; u += 512) ((LAS unsigned*)(lds + LDSCTL_OFF))[u] = 0u;
    __syncthreads();
    XcdBarrier bar; bar.bar = ctl + CW_BAR; bar.x = 0; bar.st = nullptr;
    if (MK_N_LAUNCHES == 1) bar = xcd_barrier_post(ctl + CW_BAR, MISC + 8);
    const int lo = args.ph_lo, hi = args.ph_hi;
#ifndef PH_MASK
#define PH_MASK 0xFFFF
#endif
#define IN(k) (((PH_MASK >> (k)) & 1) && lo <= (k) && (k) < hi)
#ifndef REP_MASK
#define REP_MASK 0
#endif
#define REPS(k) (((REP_MASK >> (k)) & 1) ? 2 : 1)
#define SEAM(k) do { if (MK_N_LAUNCHES == 1 && IN(k) && IN((k) + 1)) xcd_barrier(bar); } while (0)
    const int gw = bx * 8 + wave, NGW = G * 8;

    const float* x = args.in[I_X];
    bf16_t* XN = (bf16_t*)(ws + WS_XN);
    bf16_t* Z = (bf16_t*)(ws + WS_R1);
    bf16_t* QM = (bf16_t*)(ws + WS_QM); bf16_t* KV = (bf16_t*)(ws + WS_KV); bf16_t* KR = (bf16_t*)(ws + WS_KR);
    bf16_t* YA = (bf16_t*)(ws + WS_YA); bf16_t* YB = (bf16_t*)(ws + WS_YB); bf16_t* M1 = (bf16_t*)(ws + WS_M1); bf16_t* MG = (bf16_t*)(ws + WS_R4);
    float* H1 = (float*)(ws + WS_H1); float* EB = (float*)(ws + WS_R4);
    unsigned char* XG = ws + WS_R1; unsigned char* HACT = ws + WS_R2; bf16_t* YY = (bf16_t*)(ws + WS_R1); unsigned char* XN8 = ws + WS_XN;
    bf16_t* PB = (bf16_t*)(ws + WS_PB);
    float* ROPE = (float*)(ws + WS_ROPE); float* KM = (float*)(ws + WS_KM);
    int* TILE = (int*)(ws + WS_TILE); int* AE = (int*)(ws + WS_AE); int* AP = (int*)(ws + WS_AP); float* AW = (float*)(ws + WS_AW); int* DEST = (int*)(ws + WS_DEST);
    bf16_t* WIN = (bf16_t*)(ws + WS_WIN); bf16_t* WUQ = (bf16_t*)(ws + WS_WUQ); bf16_t* WUKV = (bf16_t*)(ws + WS_WUKV); bf16_t* WOA = (bf16_t*)(ws + WS_WOA); bf16_t* WOB = (bf16_t*)(ws + WS_WOB);
    bf16_t* WOUT = (bf16_t*)(ws + WS_WOUT); bf16_t* WPG = (bf16_t*)(ws + WS_WPG); bf16_t* WPLE = (bf16_t*)(ws + WS_WPLE); unsigned char* WGU = ws + WS_WGU; unsigned char* WDN = ws + WS_WDN;

    if (IN(0)) for (int rep_ = 0; rep_ < REPS(0); ++rep_) {
        LAS float* scr = (LAS float*)(lds + wave * 16384);
        constexpr int I0 = 32 * 258, I1 = 8 * 48, I2 = 8 * 64, I3 = 16 * 64, I4 = 16 * 64, I5 = 32 * 64, I6 = 32 * 64, I7 = 4 * 64, IE = 32 * 64;
        constexpr int NSMALL = I0 + I1 + I2 + I3 + I4 + I5 + I6 + I7, NITEMS = NSMALL + 3 * 32 * IE;
        for (int it = gw; it < NITEMS; it += NGW) {
            int r = it;
            if (r < I0) { tr_mat<1>(args.in[I_W_IN], 2048, 8256, WIN, scr, lane, r); continue; } r -= I0;
            if (r < I1) { tr_mat<2>(args.in[I_W_UQ], 512, 1536, WUQ, scr, lane, r); continue; } r -= I1;
            if (r < I2) { tr_mat<0>(args.in[I_W_UKV], 512, 2048, WUKV, scr, lane, r); continue; } r -= I2;
            if (r < I3) { tr_mat<0>(args.in[I_W_O_MLA], 1024, 2048, WOA, scr, lane, r); continue; } r -= I3;
            if (r < I4) { tr_mat<0>(args.in[I_W_O_MOBA], 1024, 2048, WOB, scr, lane, r); continue; } r -= I4;
            if (r < I5) { tr_mat<0>(args.in[I_W_OUT], 2048, 2048, WOUT, scr, lane, r); continue; } r -= I5;
            if (r < I6) { tr_mat<0>(args.in[I_W_PLE_GATE], 2048, 2048, WPG, scr, lane, r); continue; } r -= I6;
            if (r < I7) { tr_mat<0>(args.in[I_W_PLE], 256, 2048, WPLE, scr, lane, r); continue; } r -= I7;
            const int which = r / (32 * IE), rr = r % (32 * IE), e = rr / IE, item = rr % IE;
            if (which == 0) tr_mat8<3>(args.in[I_W_GATE] + (size_t)e * DM * DM, 2048, 2048, WGU + (size_t)e * 4096 * 2048, scr, lane, item);
            else if (which == 1) tr_mat8<4>(args.in[I_W_UP] + (size_t)e * DM * DM, 2048, 2048, WGU + (size_t)e * 4096 * 2048, scr, lane, item);
            else tr_mat8<0>(args.in[I_W_DOWN] + (size_t)e * DM * DM, 2048, 2048, WDN + (size_t)e * 2048 * 2048, scr, lane, item);
        }
        for (int i = bx * 512 + tid; i < 192 * 2048 / 8; i += G * 512) *(u32x4*)(WIN + (size_t)8256 * 2048 + (size_t)i * 8) = (u32x4){0u, 0u, 0u, 0u};
        { const float* gn = args.in[I_ATTN_NORM];
          for (int m = gw; m < T; m += NGW) { const f32x4* xr = (const f32x4*)(x + (size_t)m * DM) + lane; f32x4 v[8]; float s = 0.f;
#pragma unroll
              for (int j = 0; j < 8; ++j) { v[j] = xr[64 * j]; s += (v[j][0] * v[j][0] + v[j][1] * v[j][1]) + (v[j][2] * v[j][2] + v[j][3] * v[j][3]); }
              const float rstd = 1.0f / sqrtf(wave_sum(s) * (1.0f / DM) + EPS);
              u32x2* o8 = (u32x2*)(XN + (size_t)m * DM) + lane;
#pragma unroll
              for (int j = 0; j < 8; ++j) { const f32x4 gv = ((const f32x4*)gn)[64 * j + lane]; u32x2 w; w.x = cvtpk(v[j][0] * rstd * gv[0], v[j][1] * rstd * gv[1]); w.y = cvtpk(v[j][2] * rstd * gv[2], v[j][3] * rstd * gv[3]); o8[64 * j] = w; } } }
        { const float* p = args.in[I_P];
          for (int i = bx * 512 + tid; i < T * 256 / 8; i += G * 512) { const f32x4 a = *(const f32x4*)(p + (size_t)i * 8), b = *(const f32x4*)(p + (size_t)i * 8 + 4); *(u32x4*)(PB + (size_t)i * 8) = pg8::pack8(a, b); } }
        for (int i = bx * 512 + tid; i < SEQ * 32; i += G * 512) { const int pos = i >> 5, j = i & 31; double rev = (double)pos * ROPE_REV[j]; rev -= floor(rev); const float fr = (float)rev;
            ROPE[2 * i] = __builtin_amdgcn_cosf(fr); ROPE[2 * i + 1] = __builtin_amdgcn_sinf(fr); }
    }
    SEAM(0);

    if (IN(1)) for (int rep_ = 0; rep_ < REPS(1); ++rep_) {
        pg8::Gemm g{DM * 2, DM * 2, DM * 2, 0, 0}; pg8::DenseOrder S; S.init(XN, DM * 2, WIN, DM * 2, T, NZ, G, bx);
        pg8::EpiStore E{Z, NZ};
        pg8::gemm_phase<pg8::EpiStore, pg8::DenseOrder>(lds, g, S, E);
    }
    SEAM(1);

    if (IN(2)) {
        const float* gq = args.in[I_QLN]; const float* gk = args.in[I_KVLN];
        for (int m = gw; m < T; m += NGW) { bf16_t* zr = Z + (size_t)m * NZ;
#pragma unroll
            for (int w2 = 0; w2 < 2; ++w2) { bf16_t* p = zr + (w2 ? ZC_KVL : ZC_QL) + lane * 8; const float* gp = (w2 ? gk : gq) + lane * 8;
                f32x4 a, b; pg8::unpack8(*(const u32x4*)p, a, b);
                const float s = (a[0] * a[0] + a[1] * a[1]) + (a[2] * a[2] + a[3] * a[3]) + (b[0] * b[0] + b[1] * b[1]) + (b[2] * b[2] + b[3] * b[3]);
                const float rstd = 1.0f / sqrtf(wave_sum(s) * (1.0f / 512.0f) + EPS);
                const f32x4 g0 = *(const f32x4*)gp, g1 = *(const f32x4*)(gp + 4);
                *(u32x4*)p = pg8::pack8(a * rstd * g0, b * rstd * g1); }
            if (lane < 32) { const int pos = m & (SEQ - 1); const float x1 = bf2f(zr[ZC_KR + lane]), x2 = bf2f(zr[ZC_KR + 32 + lane]); const float c = ROPE[(pos * 32 + lane) * 2], s = ROPE[(pos * 32 + lane) * 2 + 1];
                *(unsigned*)(KR + (size_t)m * 64 + 2 * lane) = cvtpk(x1 * c - x2 * s, x1 * s + x2 * c); } }
        { LAS float* part = (LAS float*)lds;
          for (int it = bx; it < NBATCH * 8 * 16; it += G) { const int b = it >> 7, hh = (it >> 4) & 7, blk = it & 15; const int c8 = tid & 15, rg = tid >> 4;
              const bf16_t* kp = Z + (size_t)(b * SEQ + blk * 256 + rg * 8) * NZ + ZC_KB + hh * 128 + c8 * 8;
              f32x4 s0 = {0.f, 0.f, 0.f, 0.f}, s1 = {0.f, 0.f, 0.f, 0.f};
#pragma unroll
              for (int r = 0; r < 8; ++r) { f32x4 a, bq; pg8::unpack8(*(const u32x4*)(kp + (size_t)r * NZ), a, bq); s0 += a; s1 += bq; }
              *(LAS f32x4*)(part + rg * 128 + c8 * 8) = s0; *(LAS f32x4*)(part + rg * 128 + c8 * 8 + 4) = s1;
              __syncthreads();
              if (tid < 128) { float s = 0.f;
#pragma unroll
                  for (int r = 0; r < 32; ++r) s += part[r * 128 + tid];
                  KM[(size_t)it * 128 + tid] = s * (1.0f / 256.0f); }
              __syncthreads(); } }
    }
    SEAM(2);

    if (IN(3)) {
        { pg8::Gemm g{NZ * 2, 1024, 1024, 0, 0}; pg8::DenseOrder S; S.init(Z + ZC_QL, NZ * 2, WUQ, 1024, T, 1536, G, bx);
          pg8::EpiQRope E{QM, 1536, (const f32x4*)ROPE};
          pg8::gemm_phase<pg8::EpiQRope, pg8::DenseOrder>(lds, g, S, E); }
        { pg8::Gemm g{NZ * 2, 1024, 1024, 0, 0}; pg8::DenseOrder S; S.init(Z + ZC_KVL, NZ * 2, WUKV, 1024, T, 2048, G, bx);
          pg8::EpiStore E{KV, 2048};
          pg8::gemm_phase<pg8::EpiStore, pg8::DenseOrder>(lds, g, S, E); }
    }
    SEAM(3);

    if (IN(4)) for (int rep_ = 0; rep_ < REPS(4); ++rep_) {
#ifndef NO_MLA
        for (int it = bx; it < 256; it += G) {
            const int xcd = it & 7, k = it >> 3, bh = xcd * 4 + (k >> 3), pr = k & 7, b = bh >> 3, hh = bh & 7;
#pragma unroll 1
            for (int pass = 0; pass < 2; ++pass) { const int qb = pass ? pr : 15 - pr;
                att::attn_unit<true>((char*)lds_raw, hh, qb, QM + (size_t)b * SEQ * 1536 + hh * 192, 1536, KV + (size_t)b * SEQ * 2048 + hh * 256, 2048, KR + (size_t)b * SEQ * 64,
                                     KV + (size_t)b * SEQ * 2048 + hh * 256 + 128, 2048, YA + (size_t)b * SEQ * 1024 + hh * 128, 1024, nullptr, nullptr); }
        }
#endif
#ifndef NO_MOBA
        for (int it = bx; it < 256; it += G) {
            const int xcd = it & 7, k = it >> 3, bh = xcd * 4 + (k >> 3), pr = k & 7, b = bh >> 3, hh = bh & 7;
            const bf16_t* zb = Z + (size_t)b * SEQ * NZ + hh * 128;
#pragma unroll 1
            for (int pass = 0; pass < 2; ++pass) { const int qb = pass ? pr : 15 - pr;
                att::attn_unit<false>((char*)lds_raw, hh, qb, zb + ZC_QB, NZ, zb + ZC_KB, NZ, nullptr, zb + ZC_VB, NZ, YB + (size_t)b * SEQ * 1024 + hh * 128, 1024,
                                      KM + (size_t)bh * 16 * 128, args.in[I_REL_BIAS]); }
        }
#endif
    }
    SEAM(4);

    if (IN(5)) {
        pg8::Gemm g{2048, 2048, 2048, 0, 0}; pg8::DenseOrder S; S.init(YA, 2048, WOA, 2048, T, DM, G, bx);
        pg8::EpiGate<false> E{Z + ZC_GA, NZ, nullptr, M1, DM};
        pg8::gemm_phase<pg8::EpiGate<false>, pg8::DenseOrder>(lds, g, S, E);
    }
    SEAM(5);
    if (IN(6)) {
        pg8::Gemm g{2048, 2048, 2048, 0, 0}; pg8::DenseOrder S; S.init(YB, 2048, WOB, 2048, T, DM, G, bx);
        pg8::EpiGate<true> E{Z + ZC_GB, NZ, M1, MG, DM};
        pg8::gemm_phase<pg8::EpiGate<true>, pg8::DenseOrder>(lds, g, S, E);
    }
    SEAM(6);
    if (IN(7)) {
        pg8::Gemm g{DM * 2, DM * 2, DM * 2, 0, 0}; pg8::DenseOrder S; S.init(MG, DM * 2, WOUT, DM * 2, T, DM, G, bx);
        pg8::EpiResF32 E{x, H1, DM};
        pg8::gemm_phase<pg8::EpiResF32, pg8::DenseOrder>(lds, g, S, E);
    }
    SEAM(7);

    if (IN(8)) {
        LAS float* xs = (LAS float*)lds;
        LAS float* part = (LAS float*)(lds + 65536);
        LAS float* lg = (LAS float*)(lds + 65536 + 16384);
        const float* gn = args.in[I_MOE_NORM]; const float* wr_ = args.in[I_W_ROUTER]; const float* br = args.in[I_B_ROUTER];
        for (int ch = bx; ch < T / 8; ch += G) {
            const int m = ch * 8 + wave;
            { const f32x4* xr = (const f32x4*)(H1 + (size_t)m * DM) + lane; f32x4 v[8]; float s = 0.f;
#pragma unroll
              for (int j = 0; j < 8; ++j) { v[j] = xr[64 * j]; s += (v[j][0] * v[j][0] + v[j][1] * v[j][1]) + (v[j][2] * v[j][2] + v[j][3] * v[j][3]); }
              const float rstd = 1.0f / sqrtf(wave_sum(s) * (1.0f / DM) + EPS);
              unsigned* o4 = (unsigned*)(XN8 + (size_t)m * DM) + lane;
#pragma unroll
              for (int j = 0; j < 8; ++j) { const f32x4 gv = ((const f32x4*)gn)[64 * j + lane]; const f32x4 y = v[j] * rstd * gv;
                  o4[64 * j] = cvt4_fp8(y[0], y[1], y[2], y[3]); *(LAS f32x4*)(xs + wave * DM + (64 * j + lane) * 4) = y; } }
            __syncthreads();
            { const int e = tid & 31, ks = tid >> 5; float acc[8];
#pragma unroll
              for (int r = 0; r < 8; ++r) acc[r] = 0.f;
              for (int k4 = 0; k4 < 32; ++k4) { const int k = ks * 128 + k4 * 4;
                  const float w0 = wr_[(size_t)(k + 0) * 32 + e], w1 = wr_[(size_t)(k + 1) * 32 + e], w2 = wr_[(size_t)(k + 2) * 32 + e], w3 = wr_[(size_t)(k + 3) * 32 + e];
#pragma unroll
                  for (int r = 0; r < 8; ++r) { const f32x4 xv = *(const LAS f32x4*)(xs + r * DM + k); acc[r] += xv[0] * w0 + xv[1] * w1 + xv[2] * w2 + xv[3] * w3; } }
#pragma unroll
              for (int r = 0; r < 8; ++r) part[(ks * 8 + r) * 32 + e] = acc[r]; }
            __syncthreads();
            if (tid < 256) { const int r = tid >> 5, e = tid & 31; float s = br[e];
#pragma unroll
                for (int ks = 0; ks < 16; ++ks) s += part[(ks * 8 + r) * 32 + e];
                lg[r * 32 + e] = s; }
            __syncthreads();
            if (tid < 8) { const int tok = ch * 8 + tid; float v0 = -__builtin_inff(), v1 = v0, v2 = v0, v3 = v0; int i0 = 0, i1 = 0, i2 = 0, i3 = 0;
                for (int e = 0; e < 32; ++e) { const float xv = lg[tid * 32 + e];
                    if (xv > v0) { v3 = v2; i3 = i2; v2 = v1; i2 = i1; v1 = v0; i1 = i0; v0 = xv; i0 = e; }
                    else if (xv > v1) { v3 = v2; i3 = i2; v2 = v1; i2 = i1; v1 = xv; i1 = e; }
                    else if (xv > v2) { v3 = v2; i3 = i2; v2 = xv; i2 = e; }
                    else if (xv > v3) { v3 = xv; i3 = e; } }
                const float e1 = __expf(v1 - v0), e2 = __expf(v2 - v0), e3 = __expf(v3 - v0), inv = 1.0f / (1.0f + e1 + e2 + e3);
                const int p0 = (int)atomicAdd(ctl + CW_CNT + 64 * i0, 1u), p1 = (int)atomicAdd(ctl + CW_CNT + 64 * i1, 1u), p2 = (int)atomicAdd(ctl + CW_CNT + 64 * i2, 1u), p3 = (int)atomicAdd(ctl + CW_CNT + 64 * i3, 1u);
                *(int4*)(AE + tok * 4) = make_int4(i0, i1, i2, i3); *(int4*)(AP + tok * 4) = make_int4(p0, p1, p2, p3); *(f32x4*)(AW + tok * 4) = (f32x4){inv, e1 * inv, e2 * inv, e3 * inv}; }
            __syncthreads();
        }
    }
    SEAM(8);

    if (IN(9)) {
        LAS int* pst = (LAS int*)lds;
        if (tid == 0) { int run = 0;
            for (int e = 0; e < NE; ++e) { const int c = (int)__hip_atomic_load(ctl + CW_CNT + 64 * e, RLX_AGENT); pst[e] = run; pst[32 + e] = c; run += (c + 255) & ~255; }
            pst[64] = run >> 8; }
        __syncthreads();
        if (bx == 0) { if (tid == 0) TILE[0] = pst[64];
            if (tid < NE) { const int s = pst[tid] >> 8, n = (pst[32 + tid] + 255) >> 8; for (int i = 0; i < n; ++i) TILE[16 + s + i] = tid; } }
        for (int a = gw; a < NA; a += NGW) { const int tok = a >> 2; const int e = AE[a], dest = pst[e] + AP[a];
            if (lane == 0) DEST[a] = dest;
            const u32x4* src = (const u32x4*)(XN8 + (size_t)tok * DM) + lane; u32x4* dst = (u32x4*)(XG + (size_t)dest * DM) + lane;
#pragma unroll
            for (int j = 0; j < 2; ++j) dst[64 * j] = src[64 * j]; }
        for (int e = 0; e < NE; ++e) { const int r0 = pst[e] + pst[32 + e], r1 = pst[e] + ((pst[32 + e] + 255) & ~255);
            for (int r = r0 + gw; r < r1; r += NGW) { u32x4* dst = (u32x4*)(XG + (size_t)r * DM) + lane;
#pragma unroll
                for (int j = 0; j < 2; ++j) dst[64 * j] = (u32x4){0u, 0u, 0u, 0u}; } }
        __syncthreads();
    }
    SEAM(9);

    if (IN(10)) for (int rep_ = 0; rep_ < REPS(10); ++rep_) {
        pg8::Gemm g{DM, DM, DM, 0x7f7f7f7f, 0x79797979}; pg8::GroupedOrder S; S.tile_e = TILE + 16; S.ntiles = __builtin_amdgcn_readfirstlane(ld_agent_i(TILE)); S.nN = 16; S.G = G; S.c = bx;
        S.A = (const char*)XG; S.B = (const char*)WGU; S.atile = (size_t)256 * DM; S.btile = (size_t)256 * DM; S.bexp = (size_t)4096 * DM;
        pg8::EpiSwiglu E{args.in[I_B_GATE], args.in[I_B_UP], HACT};
        pg8::gemm_phase<pg8::EpiSwiglu, pg8::GroupedOrder, true>(lds, g, S, E);
    }
    SEAM(10);
    if (IN(11)) {
        pg8::Gemm g{DM, DM, DM, 0x7f7f7f7f, 0x79797979}; pg8::GroupedOrder S; S.tile_e = TILE + 16; S.ntiles = __builtin_amdgcn_readfirstlane(ld_agent_i(TILE)); S.nN = 8; S.G = G; S.c = bx;
        S.A = (const char*)HACT; S.B = (const char*)WDN; S.atile = (size_t)256 * DM; S.btile = (size_t)256 * DM; S.bexp = (size_t)2048 * DM;
        pg8::EpiDown E{args.in[I_B_DOWN], YY};
        pg8::gemm_phase<pg8::EpiDown, pg8::GroupedOrder, true>(lds, g, S, E);
    }
    SEAM(11);

    if (IN(12)) {
        const float* gn = args.in[I_PLE_NORM]; int ln = lane; asm volatile("" : "+v"(ln));
        for (int m = gw; m < T; m += NGW) { f32x4* hr = (f32x4*)(H1 + (size_t)m * DM) + ln; f32x4 v[8];
#pragma unroll
            for (int j = 0; j < 8; ++j) v[j] = hr[64 * j];
#pragma unroll
            for (int k = 0; k < 4; ++k) { const int dest = DEST[m * 4 + k]; const float w = AW[m * 4 + k]; const u32x2* yr = (const u32x2*)(YY + (size_t)dest * DM) + ln;
#pragma unroll
                for (int j = 0; j < 8; ++j) { const u32x2 y = yr[64 * j]; v[j][0] += w * bflo(y.x); v[j][1] += w * bfhi(y.x); v[j][2] += w * bflo(y.y); v[j][3] += w * bfhi(y.y); } }
            float s = 0.f;
#pragma unroll
            for (int j = 0; j < 8; ++j) { hr[64 * j] = v[j]; s += (v[j][0] * v[j][0] + v[j][1] * v[j][1]) + (v[j][2] * v[j][2] + v[j][3] * v[j][3]); }
            const float rstd = 1.0f / sqrtf(wave_sum(s) * (1.0f / DM) + EPS);
            u32x2* o8 = (u32x2*)(XN + (size_t)m * DM) + ln;
#pragma unroll
            for (int j = 0; j < 8; ++j) { const f32x4 gv = ((const f32x4*)gn)[64 * j + ln]; u32x2 w; w.x = cvtpk(v[j][0] * rstd * gv[0], v[j][1] * rstd * gv[1]); w.y = cvtpk(v[j][2] * rstd * gv[2], v[j][3] * rstd * gv[3]); o8[64 * j] = w; } }
    }
    SEAM(12);

    if (IN(13)) {
        pg8::Gemm g{512, 512, 512, 0, 0}; pg8::DenseOrder S; S.init(PB, 512, WPLE, 512, T, DM, G, bx);
        pg8::EpiResF32 E{nullptr, EB, DM};
        pg8::gemm_phase<pg8::EpiResF32, pg8::DenseOrder>(lds, g, S, E);
    }
    SEAM(13);
    if (IN(14)) {
        pg8::Gemm g{DM * 2, DM * 2, DM * 2, 0, 0}; pg8::DenseOrder S; S.init(XN, DM * 2, WPG, DM * 2, T, DM, G, bx);
        pg8::EpiPle E{H1, EB, args.out};
        pg8::gemm_phase<pg8::EpiPle, pg8::DenseOrder>(lds, g, S, E);
    }
    SEAM(14);
    if (IN(15)) {
        const float* gn = args.in[I_FINAL_NORM]; int ln = lane; asm volatile("" : "+v"(ln));
        for (int m = gw; m < T; m += NGW) { f32x4* xr = (f32x4*)(args.out + (size_t)m * DM) + ln; f32x4 v[8]; float s = 0.f;
#pragma unroll
            for (int j = 0; j < 8; ++j) { v[j] = xr[64 * j]; s += (v[j][0] * v[j][0] + v[j][1] * v[j][1]) + (v[j][2] * v[j][2] + v[j][3] * v[j][3]); }
            const float rstd = 1.0f / sqrtf(wave_sum(s) * (1.0f / DM) + EPS);
#pragma unroll
            for (int j = 0; j < 8; ++j) { const f32x4 gv = ((const f32x4*)gn)[64 * j + ln]; xr[64 * j] = v[j] * rstd * gv; } }
    }
#undef IN
#undef SEAM
}

extern "C" void kernel_launch(void* const* d_in, const int* in_sizes, int n_in, void* d_out, int out_size, void* d_ws, size_t ws_size, hipStream_t stream) {
    static int grid = 0;
    if (grid == 0) {
        if (n_in != 25 || out_size != T * DM || ws_size < WS_END) { fprintf(stderr, "kernel_launch: unexpected shapes (n_in %d, out %d, ws %zu < %zu)\n", n_in, out_size, ws_size, (size_t)WS_END); grid = -1; return; }
        int dev = 0, cus = 0, per_cu = 0;
        if (hipGetDevice(&dev) != hipSuccess || hipDeviceGetAttribute(&cus, hipDeviceAttributeMultiprocessorCount, dev) != hipSuccess) { grid = -1; return; }
        if (hipFuncSetAttribute((const void*)mega_fwd, hipFuncAttributeMaxDynamicSharedMemorySize, LDS_BYTES) != hipSuccess) { fprintf(stderr, "kernel_launch: hipFuncSetAttribute failed\n"); grid = -1; return; }
        if (hipOccupancyMaxActiveBlocksPerMultiprocessor(&per_cu, (const void*)mega_fwd, 512, LDS_BYTES) != hipSuccess || per_cu < 1) { fprintf(stderr, "kernel_launch: occupancy query says %d blocks per CU\n", per_cu); }
        (void)hipGetLastError();
        grid = cus;
    }
    if (grid < 0) return;
    (void)in_sizes;
    if (hipMemsetAsync((char*)d_ws + WS_CTL, 0, CTL_ZERO_BYTES, stream) != hipSuccess) return;
    Args a{};
    for (int i = 0; i < 25; ++i) a.in[i] = (const float*)d_in[i];
    a.out = (float*)d_out; a.ws = (unsigned char*)d_ws;
    for (int li = 0; li < MK_N_LAUNCHES; ++li) {
        a.ph_lo = (MK_N_LAUNCHES == 1) ? 0 : li; a.ph_hi = (MK_N_LAUNCHES == 1) ? NPHASE : li + 1;
        hipLaunchKernelGGL(mega_fwd, dim3(grid), dim3(512), LDS_BYTES, stream, a);
    }
}
```

```cpp
#include <hip/hip_runtime.h>
#include <cstdio>
#include <cstdint>

#ifndef MK_N_LAUNCHES
#define MK_N_LAUNCHES 1
#endif

#define GAS __attribute__((address_space(1)))
#define LAS __attribute__((address_space(3)))
typedef unsigned short bf16_t;
typedef short bf16x8 __attribute__((ext_vector_type(8)));
typedef short s16x4 __attribute__((ext_vector_type(4)));
typedef float f32x2 __attribute__((ext_vector_type(2)));
typedef float f32x4 __attribute__((ext_vector_type(4)));
typedef float f32x16 __attribute__((ext_vector_type(16)));
typedef unsigned u32x2 __attribute__((ext_vector_type(2)));
typedef unsigned u32x4 __attribute__((ext_vector_type(4)));
typedef int i32x4 __attribute__((ext_vector_type(4)));
typedef int i32x8 __attribute__((ext_vector_type(8)));

constexpr int DM = 2048, NBATCH = 4, SEQ = 4096, T = NBATCH * SEQ;
constexpr int NZ = 8448;
constexpr int ZC_QL = 0, ZC_KVL = 512, ZC_QB = 1024, ZC_KB = 2048, ZC_VB = 3072, ZC_GA = 4096, ZC_GB = 6144, ZC_KR = 8192;
constexpr int NE = 32, TOPK = 4, NA = T * TOPK;
constexpr int PMAX = NA + NE * 256;
constexpr int MAXTILES = PMAX / 256;
constexpr float EPS = 1e-6f;
constexpr int NPHASE = 16;

constexpr size_t MiB = 1u << 20;
constexpr size_t WS_CTL = 0, CTL_ZERO_BYTES = 1 * MiB;
constexpr size_t WS_ROPE = 1 * MiB;
constexpr size_t WS_KM = 2 * MiB;
constexpr size_t WS_TILE = 3 * MiB;
constexpr size_t WS_AE = 4 * MiB, WS_AP = 5 * MiB, WS_AW = 6 * MiB, WS_DEST = 7 * MiB;
constexpr size_t WS_PB = 8 * MiB;
constexpr size_t WS_KR = 16 * MiB;
constexpr size_t WS_WIN = 18 * MiB;
constexpr size_t WS_WUQ = 51 * MiB, WS_WUKV = 53 * MiB, WS_WOA = 55 * MiB, WS_WOB = 59 * MiB, WS_WOUT = 63 * MiB, WS_WPG = 71 * MiB, WS_WPLE = 79 * MiB;
constexpr size_t WS_WGU = 80 * MiB;
constexpr size_t WS_WDN = 336 * MiB;
constexpr size_t WS_H1 = 464 * MiB;
constexpr size_t WS_XN = 592 * MiB;
constexpr size_t WS_R4 = 656 * MiB;
constexpr size_t WS_R1 = 784 * MiB;
constexpr size_t WS_R2 = 1072 * MiB;
constexpr size_t WS_QM = WS_R2, WS_KV = WS_R2 + 48 * MiB, WS_YA = WS_R2 + 112 * MiB, WS_YB = WS_R2 + 144 * MiB, WS_M1 = WS_R2 + 176 * MiB;
constexpr size_t WS_END = 1360 * MiB;
constexpr int CW_TMO = 0;
constexpr int CW_BAR = 4096;
constexpr int CW_CNT = 16384;

constexpr int RING_BYTES = 131072;
constexpr int LDSCTL_OFF = RING_BYTES, MISC_OFF = LDSCTL_OFF + 320;
constexpr int LDS_BYTES = 147456;

#define LDS_WAIT() asm volatile("s_waitcnt lgkmcnt(0)" ::: "memory")
#define VM_WAIT() asm volatile("s_waitcnt vmcnt(0)" ::: "memory")
#define RLX_AGENT __ATOMIC_RELAXED, __HIP_MEMORY_SCOPE_AGENT

__device__ __forceinline__ unsigned cvtpk(float lo, float hi) { unsigned r; asm volatile("v_cvt_pk_bf16_f32 %0, %1, %2" : "=v"(r) : "v"(lo), "v"(hi)); return r; }
__device__ __forceinline__ unsigned cvt4_fp8(float a, float b, float c, float d) { int w = 0; w = __builtin_amdgcn_cvt_pk_fp8_f32(a, b, w, false); w = __builtin_amdgcn_cvt_pk_fp8_f32(c, d, w, true); return (unsigned)w; }
__device__ __forceinline__ float bf2f(unsigned short b) { return __uint_as_float(((unsigned)b) << 16); }
__device__ __forceinline__ float bflo(unsigned w) { return __uint_as_float(w << 16); }
__device__ __forceinline__ float bfhi(unsigned w) { return __uint_as_float(w & 0xffff0000u); }
__device__ __forceinline__ float sigmoidf_(float x) { return __builtin_amdgcn_rcpf(1.0f + __expf(-x)); }
__device__ __forceinline__ float wave_sum(float v) {
#pragma unroll
    for (int o = 1; o < 64; o <<= 1) v += __shfl_xor(v, o);
    return v;
}
__device__ __forceinline__ int ld_agent_i(const int* p) { return __hip_atomic_load(p, RLX_AGENT); }

#define XB_TMO      128
#define XB_XCNT(j)  (256  + 64 * (j))
#define XB_XSUB(j)  (1280 + 64 * (j))
#define XB_XGEN(j)  (2304 + 64 * (j))
#define XB_TOP      3328
#define XB_TOPGEN   3392
#define XCD_BAR_WORDS 3456
#define XB_SPIN_CAP (1u << 22)

__device__ __forceinline__ unsigned xb_ld(unsigned* p)              { return __hip_atomic_load(p, __ATOMIC_RELAXED, __HIP_MEMORY_SCOPE_AGENT); }
__device__ __forceinline__ unsigned xb_add(unsigned* p, unsigned v) { return __hip_atomic_fetch_add(p, v, __ATOMIC_RELAXED, __HIP_MEMORY_SCOPE_AGENT); }
__device__ __forceinline__ unsigned xb_xcc_id() { return (unsigned)__builtin_amdgcn_s_getreg((3 << 11) | 20) & 0xFu; }
#define XB_SPIN(cond, bar) do { unsigned _sp = 0; while (cond) { __builtin_amdgcn_s_sleep(1); \
    if ((++_sp & 255u) == 0u) { if (xb_ld(&(bar)[XB_TMO])) break; if (_sp > XB_SPIN_CAP) { atomicAdd(&(bar)[XB_TMO], 1u); break; } } } } while (0)

struct XcdBarrier { unsigned* bar; unsigned x; volatile LAS unsigned* st; };

__device__ __forceinline__ XcdBarrier xcd_barrier_post(unsigned* bar, volatile LAS unsigned* st) {
    XcdBarrier b; b.bar = bar; b.x = xb_xcc_id(); b.st = st;
    if (threadIdx.x == 0) (void)xb_add(&bar[XB_XCNT(b.x)], 1u);
    return b;
}
__device__ __forceinline__ void xcd_barrier_complete(unsigned* bar, unsigned x, unsigned& nloc, unsigned& nx) {
    const unsigned G = gridDim.x * gridDim.y * gridDim.z;
    unsigned sum, cnt, mine, sp = 0u;
    for (;;) {
        sum = 0u; cnt = 0u; mine = 0u;
#pragma unroll
        for (unsigned j = 0; j < 16; ++j) { const unsigned c = xb_ld(&bar[XB_XCNT(j)]); sum += c; cnt += (c > 0u) ? 1u : 0u; mine = (j == x) ? c : mine; }
        if (sum == G) break;
        __builtin_amdgcn_s_sleep(1);
        if ((++sp & 255u) == 0u) { if (xb_ld(&bar[XB_TMO])) break; if (sp > XB_SPIN_CAP) { atomicAdd(&bar[XB_TMO], 1u); break; } }
    }
    nloc = mine > 0u ? mine : 1u; nx = cnt > 0u ? cnt : 1u;
}
__device__ __forceinline__ void xcd_barrier(const XcdBarrier& b) {
    asm volatile("s_waitcnt vmcnt(0)" ::: "memory");
    __syncthreads();
    if (threadIdx.x == 0) {
        unsigned* bar = b.bar;
        __builtin_amdgcn_s_waitcnt(0);
        unsigned nloc = b.st[0], nx = b.st[1];
        if (nloc == 0u) { xcd_barrier_complete(bar, b.x, nloc, nx); b.st[0] = nloc; b.st[1] = nx; }
        const unsigned old = xb_add(&bar[XB_XSUB(b.x)], 1u);
        const unsigned gen = old / nloc;
        if (old + 1u == (gen + 1u) * nloc) {
            __builtin_amdgcn_fence(__ATOMIC_RELEASE, "agent");
            asm volatile("s_waitcnt vmcnt(0)" ::: "memory");
            const unsigned og = xb_add(&bar[XB_TOP], 1u);
            const unsigned tg = og / nx;
            if (og + 1u == (tg + 1u) * nx) xb_add(&bar[XB_TOPGEN], 1u);
            else XB_SPIN(xb_ld(&bar[XB_TOPGEN]) == tg, bar);
            __builtin_amdgcn_fence(__ATOMIC_ACQUIRE, "agent");
            xb_add(&bar[XB_XGEN(b.x)], 1u);
            asm volatile("s_waitcnt vmcnt(0)" ::: "memory");
        } else {
            XB_SPIN(xb_ld(&bar[XB_XGEN(b.x)]) == gen, bar);
            __builtin_amdgcn_fence(__ATOMIC_ACQUIRE, "agent");
            asm volatile("s_waitcnt vmcnt(0)" ::: "memory");
        }
    }
    __syncthreads();
}

namespace pg8 {
constexpr int BM = 256, BK = 64, HALF = 128, HTB = HALF * BK * 2, STAGE_BYTES = 8 * HTB, NXCD = 8, WGM = 8;
__host__ __device__ __forceinline__ int lds_byte(int r, int c) { const int st = (r >> 4) * 2 + (c >> 5), rr = r & 15, cc = c & 31, ob = rr * 64 + cc * 2; return st * 1024 + (ob ^ (((ob >> 9) & 1) << 5)); }
__host__ __device__ __forceinline__ void stage_rc(int b, int& R, int& C) { const int st = b / 1024, sb = b % 1024, swz = sb ^ (((sb >> 9) & 1) << 5); R = (st >> 1) * 16 + swz / 64; C = (st & 1) * 32 + (swz % 64) / 2; }
__host__ __device__ __forceinline__ int perm32(int rho) { const int n = rho >> 4, i = rho & 15; return 8 * (i >> 2) + 4 * n + (i & 3); }

struct Unit { const char* A; const char* B; int row0, col0, e; };
struct Gemm { int lda, ldb, K; int sa, sb; };

struct DenseOrder {
    int nM, nN, nwg, G, c; const char* A; const char* B; size_t atile, btile;
    __device__ void init(const void* A_, int lda, const void* B_, int ldb, int M, int N, int G_, int c_) { nM = M / BM; nN = N / BM; nwg = nM * nN; G = G_; c = c_; A = (const char*)A_; B = (const char*)B_; atile = (size_t)BM * lda; btile = (size_t)BM * ldb; }
    __device__ bool next(int i, Unit& u) const {
        const int L = i * G + c; if (L >= nwg) return false;
        int wgid = L; { const int q = nwg / NXCD, r = nwg % NXCD, xcd = wgid % NXCD, off = wgid / NXCD; wgid = (xcd < r ? xcd * (q + 1) : r * (q + 1) + (xcd - r) * q) + off; }
        const int nig = WGM * nN, gid = wgid / nig, fm = gid * WGM, gsz = (nM - fm) < WGM ? (nM - fm) : WGM;
        const int pm = fm + ((wgid % nig) % gsz), pn = (wgid % nig) / gsz;
        u.row0 = pm * BM; u.col0 = pn * BM; u.e = 0; u.A = A + (size_t)pm * atile; u.B = B + (size_t)pn * btile; return true;
    }
};
struct GroupedOrder {
    const int* tile_e; int ntiles, nN, G, c; const char* A; const char* B; size_t atile, btile, bexp;
    __device__ bool next(int i, Unit& u) const {
        const int L = i * G + c; if (L >= ntiles * nN) return false;
        const int ti = L / nN, pn = L % nN;
        const int e = __builtin_amdgcn_readfirstlane(ld_agent_i(tile_e + ti));
        u.row0 = ti * BM; u.col0 = pn * BM; u.e = e; u.A = A + (size_t)ti * atile; u.B = B + (size_t)e * bexp + (size_t)pn * btile; return true;
    }
};

typedef f32x4 Acc[2][2][4][2];
__device__ __forceinline__ u32x4 pack8(f32x4 a, f32x4 b) { u32x4 w; w.x = cvtpk(a[0], a[1]); w.y = cvtpk(a[2], a[3]); w.z = cvtpk(b[0], b[1]); w.w = cvtpk(b[2], b[3]); return w; }
__device__ __forceinline__ void unpack8(u32x4 w, f32x4& a, f32x4& b) { a = (f32x4){bflo(w.x), bfhi(w.x), bflo(w.y), bfhi(w.y)}; b = (f32x4){bflo(w.z), bfhi(w.z), bflo(w.w), bfhi(w.w)}; }

struct EpiStore {
    static constexpr bool PERM = true; bf16_t* O; int ldc;
    __device__ __forceinline__ void operator()(const Acc& acc, const Unit& u, int wr, int wc, int fr, int fq) const {
        const int row0 = u.row0 + wr * 64 + fr, col0 = u.col0 + wc * 32 + 8 * fq;
#pragma unroll
        for (int ai = 0; ai < 2; ++ai)
#pragma unroll
            for (int m = 0; m < 4; ++m) { bf16_t* rowp = O + (size_t)(row0 + ai * HALF + m * 16) * ldc + col0;
#pragma unroll
                for (int bj = 0; bj < 2; ++bj) *(u32x4*)(rowp + bj * HALF) = pack8(acc[ai][bj][m][0], acc[ai][bj][m][1]); }
    }
};
struct EpiQRope {
    static constexpr bool PERM = true; bf16_t* O; int ldc; const f32x4* rope;
    __device__ __forceinline__ void operator()(const Acc& acc, const Unit& u, int wr, int wc, int fr, int fq) const {
        const int row0 = u.row0 + wr * 64 + fr, col0 = u.col0 + wc * 32 + 8 * fq;
#pragma unroll
        for (int ai = 0; ai < 2; ++ai)
#pragma unroll
            for (int m = 0; m < 4; ++m) { const int row = row0 + ai * HALF + m * 16, pos = row & (SEQ - 1); bf16_t* rowp = O + (size_t)row * ldc + col0;
#pragma unroll
                for (int bj = 0; bj < 2; ++bj) { f32x4 v0 = acc[ai][bj][m][0], v1 = acc[ai][bj][m][1]; const int d = (col0 + bj * HALF) % 192;
                    if (d >= 128) { const int jj = (d - 128) >> 1; const f32x4 c01 = rope[pos * 16 + (jj >> 1)], c23 = rope[pos * 16 + (jj >> 1) + 1];
                        f32x4 w0, w1;
                        w0[0] = v0[0] * c01[0] - v0[1] * c01[1]; w0[1] = v0[0] * c01[1] + v0[1] * c01[0];
                        w0[2] = v0[2] * c01[2] - v0[3] * c01[3]; w0[3] = v0[2] * c01[3] + v0[3] * c01[2];
                        w1[0] = v1[0] * c23[0] - v1[1] * c23[1]; w1[1] = v1[0] * c23[1] + v1[1] * c23[0];
                        w1[2] = v1[2] * c23[2] - v1[3] * c23[3]; w1[3] = v1[2] * c23[3] + v1[3] * c23[2];
                        v0 = w0; v1 = w1; }
                    *(u32x4*)(rowp + bj * HALF) = pack8(v0, v1); } }
    }
};
template <bool HAS_PREV, bool OUT8> struct EpiGate {
    static constexpr bool PERM = true; const bf16_t* G; int ldg; const bf16_t* prev; void* O; int ldc;
    __device__ __forceinline__ void operator()(const Acc& acc, const Unit& u, int wr, int wc, int fr, int fq) const {
        const int row0 = u.row0 + wr * 64 + fr, col0 = u.col0 + wc * 32 + 8 * fq;
#pragma unroll
        for (int ai = 0; ai < 2; ++ai)
#pragma unroll
            for (int m = 0; m < 4; ++m) { const int row = row0 + ai * HALF + m * 16;
#pragma unroll
                for (int bj = 0; bj < 2; ++bj) { const int col = col0 + bj * HALF;
                    f32x4 g0, g1; unpack8(*(const u32x4*)(G + (size_t)row * ldg + col), g0, g1);
                    f32x4 v0 = acc[ai][bj][m][0], v1 = acc[ai][bj][m][1];
#pragma unroll
                    for (int j = 0; j < 4; ++j) { v0[j] *= sigmoidf_(g0[j]); v1[j] *= sigmoidf_(g1[j]); }
                    if (HAS_PREV) { f32x4 p0, p1; unpack8(*(const u32x4*)(prev + (size_t)row * ldc + col), p0, p1); v0 += p0; v1 += p1; }
                    if constexpr (OUT8) { u32x2 w; w.x = cvt4_fp8(v0[0], v0[1], v0[2], v0[3]); w.y = cvt4_fp8(v1[0], v1[1], v1[2], v1[3]); *(u32x2*)((unsigned char*)O + (size_t)row * ldc + col) = w; }
                    else *(u32x4*)((bf16_t*)O + (size_t)row * ldc + col) = pack8(v0, v1); } }
    }
};
struct EpiResF32 {
    static constexpr bool PERM = false; const float* base; float* C; int ldc;
    __device__ __forceinline__ void operator()(const Acc& acc, const Unit& u, int wr, int wc, int fr, int fq) const {
        const int row0 = u.row0 + wr * 64 + fr, col0 = u.col0 + wc * 32 + 4 * fq;
#pragma unroll
        for (int ai = 0; ai < 2; ++ai)
#pragma unroll
            for (int m = 0; m < 4; ++m) { const size_t off = (size_t)(row0 + ai * HALF + m * 16) * ldc + col0;
#pragma unroll
                for (int bj = 0; bj < 2; ++bj)
#pragma unroll
                    for (int n = 0; n < 2; ++n) { const f32x4 b = base ? *(const f32x4*)(base + off + bj * HALF + n * 16) : (f32x4){0.f, 0.f, 0.f, 0.f}; *(f32x4*)(C + off + bj * HALF + n * 16) = b + acc[ai][bj][m][n]; } }
    }
};
struct EpiSwiglu {
    static constexpr bool PERM = true; const float* bg; const float* bu; unsigned char* O;
    __device__ __forceinline__ void operator()(const Acc& acc, const Unit& u, int wr, int wc, int fr, int fq) const {
        const int row0 = u.row0 + wr * 64 + fr, hc = (u.col0 >> 1) + wc * 32 + 8 * fq;
        const float* bgp = bg + (size_t)u.e * DM + hc; const float* bup = bu + (size_t)u.e * DM + hc;
        const f32x4 bg0 = *(const f32x4*)bgp, bg1 = *(const f32x4*)(bgp + 4), bu0 = *(const f32x4*)bup, bu1 = *(const f32x4*)(bup + 4);
#pragma unroll
        for (int ai = 0; ai < 2; ++ai)
#pragma unroll
            for (int m = 0; m < 4; ++m) { f32x4 g0 = acc[ai][0][m][0] + bg0, g1 = acc[ai][0][m][1] + bg1, u0 = acc[ai][1][m][0] + bu0, u1 = acc[ai][1][m][1] + bu1, r0, r1;
#pragma unroll
                for (int j = 0; j < 4; ++j) {
                    const float ga = fminf(g0[j], 7.0f), gb = fminf(g1[j], 7.0f);
                    const float ua = fminf(fmaxf(u0[j], -7.0f), 7.0f), ub = fminf(fmaxf(u1[j], -7.0f), 7.0f);
                    r0[j] = ga * sigmoidf_(1.702f * ga) * (ua + 1.0f); r1[j] = gb * sigmoidf_(1.702f * gb) * (ub + 1.0f); }
                u32x2 w; w.x = cvt4_fp8(r0[0], r0[1], r0[2], r0[3]); w.y = cvt4_fp8(r1[0], r1[1], r1[2], r1[3]);
                *(u32x2*)(O + (size_t)(row0 + ai * HALF + m * 16) * DM + hc) = w; }
    }
};
struct EpiDown {
    static constexpr bool PERM = true; const float* bd; bf16_t* O;
    __device__ __forceinline__ void operator()(const Acc& acc, const Unit& u, int wr, int wc, int fr, int fq) const {
        const int row0 = u.row0 + wr * 64 + fr, col0 = u.col0 + wc * 32 + 8 * fq;
        const float* bp = bd + (size_t)u.e * DM + col0;
        f32x4 bv[2][2];
#pragma unroll
        for (int bj = 0; bj < 2; ++bj) { bv[bj][0] = *(const f32x4*)(bp + bj * HALF); bv[bj][1] = *(const f32x4*)(bp + bj * HALF + 4); }
#pragma unroll
        for (int ai = 0; ai < 2; ++ai)
#pragma unroll
            for (int m = 0; m < 4; ++m) { bf16_t* rowp = O + (size_t)(row0 + ai * HALF + m * 16) * DM + col0;
#pragma unroll
                for (int bj = 0; bj < 2; ++bj) *(u32x4*)(rowp + bj * HALF) = pack8(acc[ai][bj][m][0] + bv[bj][0], acc[ai][bj][m][1] + bv[bj][1]); }
    }
};
struct EpiPle {
    static constexpr bool PERM = false; const float* h; const float* emb; float* out;
    __device__ __forceinline__ void operator()(const Acc& acc, const Unit& u, int wr, int wc, int fr, int fq) const {
        const int row0 = u.row0 + wr * 64 + fr, col0 = u.col0 + wc * 32 + 4 * fq;
#pragma unroll
        for (int ai = 0; ai < 2; ++ai)
#pragma unroll
            for (int m = 0; m < 4; ++m) { const size_t off = (size_t)(row0 + ai * HALF + m * 16) * DM + col0;
#pragma unroll
                for (int bj = 0; bj < 2; ++bj)
#pragma unroll
                    for (int n = 0; n < 2; ++n) { const size_t o = off + bj * HALF + n * 16; const f32x4 hv = *(const f32x4*)(h + o), ev = *(const f32x4*)(emb + o); f32x4 a = acc[ai][bj][m][n], r;
#pragma unroll
                        for (int j = 0; j < 4; ++j) r[j] = hv[j] + ev[j] * sigmoidf_(a[j]);
                        *(f32x4*)(out + o) = r; } }
    }
};

template <class Epi, class Sched, bool F8 = false>
__device__ __forceinline__ void gemm_phase(LAS unsigned char* lds, const Gemm g, const Sched& S, const Epi& E) {
    const int tid = threadIdx.x, wid = __builtin_amdgcn_readfirstlane(tid >> 6), lane = tid & 63, wr = wid >> 2, wc = wid & 3, fr = lane & 15, fq = lane >> 4;
    const int nt = g.K / (BK * 2);
    unsigned voffA[2], voffB[2];
#pragma unroll
    for (int i = 0; i < 2; ++i) { int R, C; stage_rc(tid * 16 + i * 8192, R, C); const int Rb = Epi::PERM ? ((R & ~31) + perm32(R & 31)) : R;
        voffA[i] = (unsigned)(R * g.lda + C * 2); voffB[i] = (unsigned)(Rb * g.ldb + C * 2); }
    const size_t kstep = (size_t)(BK * 2);
    const size_t hstepA = (size_t)HALF * g.lda, hstepB = (size_t)HALF * g.ldb;
    const unsigned ldsw = (unsigned)wid * 1024u, ldsb = (unsigned)(uintptr_t)lds;
    const int aoff = lds_byte(wr * 64 + fr, fq * 8), boff = lds_byte(wc * 32 + fr, fq * 8);
#define PG8_SA(b, h) (((b) * 2 + (h)) * HTB)
#define PG8_SB(b, h) ((4 + (b) * 2 + (h)) * HTB)
#define PG8_STAGE(bufoff, gbase, voff) do { _Pragma("unroll") for (int _i = 0; _i < 2; ++_i) \
        asm volatile("s_mov_b32 m0, %0\n\ts_nop 0\n\tglobal_load_lds_dwordx4 %1, %2" :: "s"(ldsb + (unsigned)(bufoff) + ldsw + _i * 8192u), "v"((voff)[_i]), "s"((const char*)(gbase)) : "m0", "memory"); } while (0)
#define PG8_LDA(dst, b, h) do { _Pragma("unroll") for (int m = 0; m < 4; ++m) { \
        if constexpr (F8) dst##8[m] = __builtin_shufflevector(*(const LAS i32x4*)(lds + PG8_SA(b, h) + aoff + m * 2048), *(const LAS i32x4*)(lds + PG8_SA(b, h) + aoff + m * 2048 + 1024), 0, 1, 2, 3, 4, 5, 6, 7); \
        else { _Pragma("unroll") for (int k = 0; k < 2; ++k) dst[m][k] = *(const LAS bf16x8*)(lds + PG8_SA(b, h) + aoff + m * 2048 + k * 1024); } } } while (0)
#define PG8_LDB(dst, b, h) do { _Pragma("unroll") for (int n = 0; n < 2; ++n) { \
        if constexpr (F8) dst##8[n] = __builtin_shufflevector(*(const LAS i32x4*)(lds + PG8_SB(b, h) + boff + n * 2048), *(const LAS i32x4*)(lds + PG8_SB(b, h) + boff + n * 2048 + 1024), 0, 1, 2, 3, 4, 5, 6, 7); \
        else { _Pragma("unroll") for (int k = 0; k < 2; ++k) dst[n][k] = *(const LAS bf16x8*)(lds + PG8_SB(b, h) + boff + n * 2048 + k * 1024); } } } while (0)
#define PG8_MMA(ai, bj, At, Bt) do { __builtin_amdgcn_s_setprio(1); _Pragma("unroll") for (int m = 0; m < 4; ++m) _Pragma("unroll") for (int n = 0; n < 2; ++n) { \
        if constexpr (F8) { asm volatile("v_mfma_scale_f32_16x16x128_f8f6f4 %0, %1, %2, %0, %3, %4 op_sel_hi:[0,0,0]" : "+v"(acc[ai][bj][m][n]) : "v"(Bt##8[n]), "v"(At##8[m]), "v"(g.sb), "v"(g.sa)); } \
        else { _Pragma("unroll") for (int k = 0; k < 2; ++k) acc[ai][bj][m][n] = __builtin_amdgcn_mfma_f32_16x16x32_bf16(Bt[n][k], At[m][k], acc[ai][bj][m][n], 0, 0, 0); } } \
        __builtin_amdgcn_s_setprio(0); } while (0)
#define PG8_WAIT_V(n) asm volatile("s_waitcnt vmcnt(" #n ")" ::: "memory")
#define PG8_WAIT_L(n) asm volatile("s_waitcnt lgkmcnt(" #n ")" ::: "memory")
#define PG8_BAR __builtin_amdgcn_s_barrier()
#define PG8_SCHED __builtin_amdgcn_sched_barrier(0)
    Unit cur, nxt; int ui = 0;
    if (!S.next(0, cur)) return;
    f32x4 acc[2][2][4][2];
#pragma unroll
    for (int a = 0; a < 2; ++a)
#pragma unroll
        for (int b = 0; b < 2; ++b)
#pragma unroll
            for (int m = 0; m < 4; ++m)
#pragma unroll
                for (int n = 0; n < 2; ++n) acc[a][b][m][n] = (f32x4){0.f, 0.f, 0.f, 0.f};
    bf16x8 At[4][2], B0[2][2], B1[2][2]; i32x8 At8[4], B08[2], B18[2];
    const char* cA = cur.A; const char* cB = cur.B;
    PG8_STAGE(PG8_SB(0, 0), cB, voffB); PG8_STAGE(PG8_SB(0, 1), cB + hstepB, voffB); PG8_STAGE(PG8_SA(0, 0), cA, voffA); PG8_STAGE(PG8_SA(0, 1), cA + hstepA, voffA);
    if (wr == 1) PG8_BAR;
    PG8_WAIT_V(2); PG8_BAR;
    PG8_STAGE(PG8_SB(1, 0), cB + kstep, voffB); PG8_STAGE(PG8_SA(1, 0), cA + kstep, voffA); PG8_STAGE(PG8_SB(1, 1), cB + hstepB + kstep, voffB);
    PG8_WAIT_V(6); PG8_BAR;
    for (;;) {
        const bool has_next = S.next(ui + 1, nxt);
        const char* nA = has_next ? nxt.A : cA; const char* nB = has_next ? nxt.B : cB;
        for (int t = 0; t < nt; t += 2) {
            const bool last = (t == nt - 2);
            const char* a1 = cA + (size_t)(t + 1) * kstep;
            const char* a2 = last ? nA : cA + (size_t)(t + 2) * kstep; const char* b2 = last ? nB : cB + (size_t)(t + 2) * kstep;
            const char* a3 = a2 + kstep; const char* b3 = b2 + kstep;
            PG8_LDB(B0, 0, 0); PG8_LDB(B1, 0, 1); PG8_SCHED; PG8_LDA(At, 0, 0); PG8_STAGE(PG8_SA(1, 1), a1 + hstepA, voffA);
            PG8_WAIT_V(8); PG8_WAIT_L(0); PG8_BAR; PG8_MMA(0, 0, At, B0); PG8_MMA(0, 1, At, B1); PG8_BAR; PG8_SCHED;
            PG8_LDA(At, 0, 1); PG8_STAGE(PG8_SB(0, 0), b2, voffB); PG8_STAGE(PG8_SB(0, 1), b2 + hstepB, voffB); PG8_STAGE(PG8_SA(0, 0), a2, voffA);
            PG8_WAIT_V(8); PG8_WAIT_L(0); PG8_BAR; PG8_MMA(1, 0, At, B0); PG8_MMA(1, 1, At, B1); PG8_BAR; PG8_SCHED;
            PG8_LDB(B0, 1, 0); PG8_LDB(B1, 1, 1); PG8_SCHED; PG8_LDA(At, 1, 0); PG8_STAGE(PG8_SA(0, 1), a2 + hstepA, voffA);
            PG8_WAIT_V(8); PG8_WAIT_L(0); PG8_BAR; PG8_MMA(0, 0, At, B0); PG8_MMA(0, 1, At, B1); PG8_BAR; PG8_SCHED;
            PG8_LDA(At, 1, 1); PG8_STAGE(PG8_SB(1, 0), b3, voffB); PG8_STAGE(PG8_SB(1, 1), b3 + hstepB, voffB); PG8_STAGE(PG8_SA(1, 0), a3, voffA);
            PG8_WAIT_V(8); PG8_WAIT_L(0); PG8_BAR; PG8_MMA(1, 0, At, B0); PG8_MMA(1, 1, At, B1); PG8_BAR; PG8_SCHED;
        }
        if (wr == 0) PG8_BAR;
        if constexpr (F8) asm volatile("s_nop 15\n\ts_nop 15" ::: "memory");
        { int l_; asm volatile("v_mbcnt_lo_u32_b32 %0, -1, 0\n\tv_mbcnt_hi_u32_b32 %0, -1, %0" : "=v"(l_)); E(acc, cur, wr, wc, l_ & 15, l_ >> 4); }
        if (!has_next) break;
#pragma unroll
        for (int a = 0; a < 2; ++a)
#pragma unroll
            for (int b = 0; b < 2; ++b)
#pragma unroll
                for (int m = 0; m < 4; ++m)
#pragma unroll
                    for (int n = 0; n < 2; ++n) acc[a][b][m][n] = (f32x4){0.f, 0.f, 0.f, 0.f};
        cur = nxt; cA = nA; cB = nB; ++ui;
        if (wr == 1) PG8_BAR;
    }
    PG8_WAIT_V(0);
    PG8_BAR;
#undef PG8_SA
#undef PG8_SB
#undef PG8_STAGE
#undef PG8_LDA
#undef PG8_LDB
#undef PG8_MMA
#undef PG8_WAIT_V
#undef PG8_WAIT_L
#undef PG8_BAR
#undef PG8_SCHED
}
}

namespace att {
constexpr int SHM_V = 64 * 128 * 2, SHM_KN = 64 * 128 * 2, SHM_KR = 64 * 64 * 2;
constexpr int OFF_KN = 2 * SHM_V, OFF_KR = OFF_KN + 2 * SHM_KN, OFF_WS = OFF_KR + 2 * SHM_KR, OFF_SEL = OFF_WS + 8 * 64 * 4, OFF_BT = OFF_SEL + 1024, OFF_KM = OFF_BT + 1024, ATT_LDS = OFF_KM + 8192;
static_assert(ATT_LDS <= RING_BYTES, "attention LDS");
__device__ __forceinline__ int v_rd_base(int lane) { return ((lane & 3) << 3) | (((lane >> 2) & 3) << 6) | (((lane >> 4) & 1) << 5) | (((lane >> 5) & 1) << 8); }
__device__ __forceinline__ int crow(int r, int hi) { return (r & 3) + 8 * (r >> 2) + 4 * hi; }
#define CROWC(r) (((r) & 3) + 8 * ((r) >> 2))
#define SBAR() __builtin_amdgcn_sched_barrier(0)

template <bool MLA>
__device__ __forceinline__ void attn_unit(char* lds, int h, int qb, const bf16_t* Qp, int ldq, const bf16_t* Kp, int ldk, const bf16_t* KRp, const bf16_t* Vp, int ldv,
                                          bf16_t* Op, int ldo, const float* KMp, const float* rel_bias) {
    constexpr int DK = MLA ? 192 : 128, NQ = DK / 16;
    constexpr float SCALE = MLA ? 0.07216878364870323f : 0.08838834764831845f;
    constexpr float C2 = 1.4426950408889634f * SCALE, THR = 8.f;
    const float NEG = -__builtin_inff();
    const int tid = threadIdx.x, wid = __builtin_amdgcn_readfirstlane(tid >> 6), lane = tid & 63, r32 = lane & 31, hi = lane >> 5;
    float* wsf = (float*)(lds + OFF_WS) + wid * 64; float* li_l = wsf; float* al_l = wsf + 32; const float* al_h = al_l + 4 * hi; const float* li_h = li_l + 4 * hi;
    unsigned* sel_l = (unsigned*)(lds + OFF_SEL); float* bt_l = (float*)(lds + OFF_BT); float* km_l = (float*)(lds + OFF_KM);
    const int q0 = qb * 256, qlo = q0 + wid * 32, qpos = qlo + r32, NT = (qb + 1) * 4;
    unsigned offKn[2], offV[2], offKr;
#pragma unroll
    for (int i = 0; i < 2; ++i) { const int pc = wid * 2 + i;
        { const int row = pc * 4 + (lane >> 4), colB = ((lane & 15) * 16) ^ ((row & 7) << 4); offKn[i] = (unsigned)(row * ldk + (colB >> 1)); }
        { const int sub = pc * 2 + (lane >> 5), kk = (sub >> 2) * 8 + ((lane & 31) >> 2), c = (sub & 3) * 32 + (lane & 3) * 8; const int k = (kk & ~0xC) | ((kk & 4) << 1) | ((kk & 8) >> 1);
          offV[i] = (unsigned)(k * ldv + c); } }
    { const int row = wid * 8 + (lane >> 3), colB = ((lane & 7) * 16) ^ ((row & 7) << 4); offKr = (unsigned)(row * 64 + (colB >> 1)); }
#define A_ISSUE(kb, buf) do { \
        _Pragma("unroll") for (int i_ = 0; i_ < 2; ++i_) { \
            __builtin_amdgcn_global_load_lds((const unsigned*)(Kp + (size_t)(kb) * ldk + offKn[i_]), (LAS unsigned*)(lds + OFF_KN + (buf) * SHM_KN + (wid * 2 + i_) * 1024), 16, 0, 0); \
            __builtin_amdgcn_global_load_lds((const unsigned*)(Vp + (size_t)(kb) * ldv + offV[i_]), (LAS unsigned*)(lds + (buf) * SHM_V + (wid * 2 + i_) * 1024), 16, 0, 0); } \
        if constexpr (MLA) __builtin_amdgcn_global_load_lds((const unsigned*)(KRp + (size_t)(kb) * 64 + offKr), (LAS unsigned*)(lds + OFF_KR + (buf) * SHM_KR + wid * 1024), 16, 0, 0); } while (0)
    A_ISSUE(0, 0);
    bf16x8 qr[NQ];
    { const bf16_t* qrow = Qp + (size_t)qpos * ldq;
#pragma unroll
      for (int d0 = 0; d0 < NQ; ++d0) qr[d0] = *(const bf16x8*)(qrow + d0 * 16 + hi * 8); }
    unsigned mysel = 0u;
    if constexpr (!MLA) {
        if (tid <= 128) { const int n = tid; int bk; if (n < 16) bk = n; else { const float v = logf((float)n * (1.0f / 16.0f)) / logf(8.0f) * 16.0f; bk = 16 + (int)v; if (bk > 31) bk = 31; }
            bt_l[tid] = rel_bias[bk * 8 + h] * (1.0f / SCALE); }
        for (int i = tid; i < 16 * 128; i += 512) km_l[i] = KMp[i];
        __syncthreads();
        { const int row = tid >> 1, half = tid & 1;
          unsigned mask;
          if (qb <= 3) mask = (1u << qb) - 1u;
          else { const bf16_t* qrow = Qp + (size_t)(q0 + row) * ldq + half * 64;
              u32x4 qv[8];
#pragma unroll
              for (int c = 0; c < 8; ++c) qv[c] = *(const u32x4*)(qrow + c * 8);
              float v0 = NEG, v1 = NEG, v2 = NEG; int i0 = 0, i1 = 0, i2 = 0;
#pragma unroll 1
              for (int n = 0; n < qb; ++n) { const float* kp = km_l + n * 128 + half * 64; float x = 0.f;
#pragma unroll
                  for (int c = 0; c < 8; ++c) { const f32x4 k0 = *(const f32x4*)(kp + c * 8), k1 = *(const f32x4*)(kp + c * 8 + 4);
                      x += bflo(qv[c].x) * k0[0] + bfhi(qv[c].x) * k0[1] + bflo(qv[c].y) * k0[2] + bfhi(qv[c].y) * k0[3] + bflo(qv[c].z) * k1[0] + bfhi(qv[c].z) * k1[1] + bflo(qv[c].w) * k1[2] + bfhi(qv[c].w) * k1[3]; }
                  x += __shfl_xor(x, 1);
                  if (x > v0) { v2 = v1; i2 = i1; v1 = v0; i1 = i0; v0 = x; i0 = n; } else if (x > v1) { v2 = v1; i2 = i1; v1 = x; i1 = n; } else if (x > v2) { v2 = x; i2 = n; } }
              mask = (1u << i0) | (1u << i1) | (1u << i2); }
          if (half == 0) sel_l[row] = mask; }
        __syncthreads();
        mysel = sel_l[wid * 32 + r32];
    }
    float m_reg = -1e30f, l_reg = 0.f; f32x16 o[4];
#pragma unroll
    for (int d = 0; d < 4; ++d)
#pragma unroll
        for (int r = 0; r < 16; ++r) o[d][r] = 0.f;
    int kan[4], kar[4];
#pragma unroll
    for (int dd = 0; dd < 4; ++dd) { kan[dd] = OFF_KN + r32 * 256 + ((dd * 32 + hi * 16) ^ ((r32 & 7) << 4)); kar[dd] = OFF_KR + r32 * 128 + ((dd * 32 + hi * 16) ^ ((r32 & 7) << 4)); }
    const int vrb = (int)(uintptr_t)lds + v_rd_base(lane);
    VM_WAIT(); __syncthreads();
    for (int t = 0; t < NT; ++t) {
        const int buf = t & 1, kb = t * 64, jb = kb >> 8;
        if (t + 1 < NT) A_ISSUE(kb + 64, buf ^ 1);
        int act;
        if (MLA || jb == qb) act = (kb <= qlo + 31) ? 1 : 0; else act = __any((int)((mysel >> jb) & 1u)) ? 1 : 0;
        act = __builtin_amdgcn_readfirstlane(act);
        if (act) {
            f32x16 p0, p1;
#pragma unroll
            for (int r = 0; r < 16; ++r) { p0[r] = 0.f; p1[r] = 0.f; }
            { const char* kn = lds + buf * SHM_KN; const char* kr = lds + buf * SHM_KR;
#pragma unroll
              for (int d0 = 0; d0 < 8; ++d0) { const char* ap = kn + kan[d0 & 3] + (d0 >> 2) * 128;
                  const bf16x8 a0 = *(const bf16x8*)ap, a1 = *(const bf16x8*)(ap + 32 * 256);
                  p0 = __builtin_amdgcn_mfma_f32_32x32x16_bf16(a0, qr[d0], p0, 0, 0, 0);
                  p1 = __builtin_amdgcn_mfma_f32_32x32x16_bf16(a1, qr[d0], p1, 0, 0, 0); }
              if constexpr (MLA) {
#pragma unroll
                  for (int d0 = 8; d0 < 12; ++d0) { const char* ap = kr + kar[d0 & 3];
                      const bf16x8 a0 = *(const bf16x8*)ap, a1 = *(const bf16x8*)(ap + 32 * 128);
                      p0 = __builtin_amdgcn_mfma_f32_32x32x16_bf16(a0, qr[d0], p0, 0, 0, 0);
                      p1 = __builtin_amdgcn_mfma_f32_32x32x16_bf16(a1, qr[d0], p1, 0, 0, 0); } } }
            const int dq = qpos - kb - 4 * hi;
            if constexpr (MLA) {
                if (kb + 63 > qlo) {
#pragma unroll
                    for (int r = 0; r < 16; ++r) { const int d0 = dq - CROWC(r); if (d0 < 0) p0[r] = NEG; if (d0 < 32) p1[r] = NEG; } }
            } else {
                const bool selq = (jb == qb) || (((mysel >> jb) & 1u) != 0u);
                if (q0 - (kb + 63) >= 128) { const float cb = bt_l[128];
#pragma unroll
                    for (int r = 0; r < 16; ++r) { p0[r] = selq ? p0[r] + cb : NEG; p1[r] = selq ? p1[r] + cb : NEG; } }
                else {
#pragma unroll
                    for (int r4 = 0; r4 < 4; ++r4) {
#pragma unroll
                        for (int rr = 0; rr < 4; ++rr) { const int r = r4 * 4 + rr; const int d0 = dq - CROWC(r), d1 = d0 - 32;
                            const float b0 = bt_l[d0 < 0 ? 0 : (d0 > 128 ? 128 : d0)], b1 = bt_l[d1 < 0 ? 0 : (d1 > 128 ? 128 : d1)];
                            p0[r] = (selq && d0 >= 0) ? p0[r] + b0 : NEG; p1[r] = (selq && d1 >= 0) ? p1[r] + b1 : NEG; }
                        SBAR(); } }
            }
            float pmax = p0[0];
#pragma unroll
            for (int r = 1; r < 16; ++r) pmax = fmaxf(pmax, p0[r]);
#pragma unroll
            for (int r = 0; r < 16; ++r) pmax = fmaxf(pmax, p1[r]);
            { auto rr = __builtin_amdgcn_permlane32_swap(__float_as_uint(pmax), __float_as_uint(pmax), false, false); pmax = fmaxf(__uint_as_float(rr[0]), __uint_as_float(rr[1])); }
            float mn, alpha;
            if (__all((pmax - m_reg) * SCALE <= THR)) { mn = m_reg; alpha = 1.f; }
            else { mn = fmaxf(m_reg, pmax); alpha = __builtin_amdgcn_exp2f((m_reg - mn) * C2); m_reg = mn; }
            const float mnL = -mn * C2;
#pragma unroll
            for (int r = 0; r < 16; ++r) { p0[r] = __builtin_amdgcn_exp2f(fmaf(p0[r], C2, mnL)); p1[r] = __builtin_amdgcn_exp2f(fmaf(p1[r], C2, mnL)); }
            float ps = 0.f;
#pragma unroll
            for (int r = 0; r < 16; ++r) ps += p0[r];
#pragma unroll
            for (int r = 0; r < 16; ++r) ps += p1[r];
            { auto rr = __builtin_amdgcn_permlane32_swap(__float_as_uint(ps), __float_as_uint(ps), false, false); ps = __uint_as_float(rr[0]) + __uint_as_float(rr[1]); }
            l_reg = l_reg * alpha + ps;
            bf16x8 pa0, pa1, pa2, pa3;
#define PK4(P, B_, OUT) do { unsigned a0_ = cvtpk(P[B_ + 0], P[B_ + 1]), a1_ = cvtpk(P[B_ + 2], P[B_ + 3]); unsigned b0_ = cvtpk(P[B_ + 4], P[B_ + 5]), b1_ = cvtpk(P[B_ + 6], P[B_ + 7]); \
            auto r0_ = __builtin_amdgcn_permlane32_swap(a0_, b0_, false, false); auto r1_ = __builtin_amdgcn_permlane32_swap(a1_, b1_, false, false); \
            u32x4 w_ = {r0_[0], r1_[0], r0_[1], r1_[1]}; OUT = *reinterpret_cast<bf16x8*>(&w_); } while (0)
            PK4(p0, 0, pa0); PK4(p0, 8, pa1); PK4(p1, 0, pa2); PK4(p1, 8, pa3);
#undef PK4
            if (__any(alpha < 1.f)) { if (hi == 0) al_l[r32] = alpha; LDS_WAIT();
#pragma unroll
                for (int r = 0; r < 16; ++r) { const float a = al_h[CROWC(r)];
#pragma unroll
                    for (int d_ = 0; d_ < 4; ++d_) o[d_][r] *= a; } }
            { const int vb0 = vrb + buf * SHM_V;
#define TRRD(dst, off) asm volatile("ds_read_b64_tr_b16 %0, %1 offset:%2" : "=&v"(dst) : "v"(vb0), "i"(off) : "memory")
#define PV_D0(d0) do { s16x4 l0, l1, l2, l3, h0, h1, h2, h3; constexpr int b_ = (d0) * 512; \
            TRRD(l0, b_); TRRD(h0, b_ + 2048); TRRD(l1, b_ + 4096); TRRD(h1, b_ + 6144); TRRD(l2, b_ + 8192); TRRD(h2, b_ + 10240); TRRD(l3, b_ + 12288); TRRD(h3, b_ + 14336); \
            asm volatile("s_waitcnt lgkmcnt(0)" ::: "memory"); SBAR(); \
            o[d0] = __builtin_amdgcn_mfma_f32_32x32x16_bf16(pa0, (bf16x8){l0[0], l0[1], l0[2], l0[3], h0[0], h0[1], h0[2], h0[3]}, o[d0], 0, 0, 0); \
            o[d0] = __builtin_amdgcn_mfma_f32_32x32x16_bf16(pa1, (bf16x8){l1[0], l1[1], l1[2], l1[3], h1[0], h1[1], h1[2], h1[3]}, o[d0], 0, 0, 0); \
            o[d0] = __builtin_amdgcn_mfma_f32_32x32x16_bf16(pa2, (bf16x8){l2[0], l2[1], l2[2], l2[3], h2[0], h2[1], h2[2], h2[3]}, o[d0], 0, 0, 0); \
            o[d0] = __builtin_amdgcn_mfma_f32_32x32x16_bf16(pa3, (bf16x8){l3[0], l3[1], l3[2], l3[3], h3[0], h3[1], h3[2], h3[3]}, o[d0], 0, 0, 0); SBAR(); } while (0)
              PV_D0(0); PV_D0(1); PV_D0(2); PV_D0(3);
#undef PV_D0
#undef TRRD
            }
        }
        VM_WAIT();
        __syncthreads();
    }
#undef A_ISSUE
    if (hi == 0) li_l[r32] = l_reg; LDS_WAIT();
    bf16_t* Ow = Op + (size_t)qlo * ldo;
#pragma unroll
    for (int r = 0; r < 16; ++r) { const int orow = CROWC(r) + 4 * hi; const float rl = __builtin_amdgcn_rcpf(li_h[CROWC(r)]);
#pragma unroll
        for (int d0 = 0; d0 < 4; ++d0) { const float v = o[d0][r] * rl; const float vn = __shfl_xor(v, 1);
            if ((r32 & 1) == 0) *(unsigned*)(Ow + (size_t)orow * ldo + d0 * 32 + r32) = cvtpk(v, vn); } }
    __syncthreads();
}
}

struct Args { const float* in[25]; float* out; unsigned char* ws; int ph_lo, ph_hi; };
enum { I_X = 0, I_P, I_ATTN_NORM, I_W_IN, I_QLN, I_KVLN, I_W_UQ, I_W_UKV, I_W_O_MLA, I_W_O_MOBA, I_W_OUT, I_REL_BIAS, I_MOE_NORM, I_W_ROUTER, I_B_ROUTER,
       I_W_GATE, I_B_GATE, I_W_UP, I_B_UP, I_W_DOWN, I_B_DOWN, I_PLE_NORM, I_W_PLE_GATE, I_W_PLE, I_FINAL_NORM };

__device__ const double ROPE_REV[32] = {
    1.59154943091895345608e-01, 1.19349370211248861917e-01, 8.94994016088910132600e-02, 6.71150830052272551196e-02, 5.03292121044870352509e-02, 3.77415847174197710556e-02, 2.83021958306233986646e-02, 2.12236527647776604399e-02,
    1.59154943091895338669e-02, 1.19349370211248861917e-02, 8.94994016088910236684e-03, 6.71150830052272533849e-03, 5.03292121044870369856e-03, 3.77415847174197719230e-03, 2.83021958306233986646e-03, 2.12236527647776621747e-03,
    1.59154943091895334333e-03, 1.19349370211248848907e-03, 8.94994016088910128263e-04, 6.71150830052272490481e-04, 5.03292121044870326488e-04, 3.77415847174197686704e-04, 2.83021958306233954120e-04, 2.12236527647776605484e-04,
    1.59154943091895323490e-04, 1.19349370211248848907e-04, 8.94994016088910182474e-05, 6.71150830052272544691e-05, 5.03292121044870353593e-05, 3.77415847174197700256e-05, 2.83021958306233960897e-05, 2.12236527647776591931e-05};

template <int MODE> __device__ __forceinline__ int map_row(int n) {
    if (MODE == 1) return n < 1024 ? n : (n < 1088 ? 8192 + (n - 1024) : n - 64);
    if (MODE == 2) { const int hh = n / 192, d = n % 192; if (d < 128) return n; const int i = d - 128; return hh * 192 + 128 + 2 * (i & 31) + (i >> 5); }
    if (MODE == 3) return (n >> 7) * 256 + (n & 127);
    if (MODE == 4) return (n >> 7) * 256 + 128 + (n & 127);
    return n;
}
template <int MODE> __device__ __forceinline__ void tr_item(const float* W, int ldw, int K, int k0, int n0, bf16_t* WT, LAS float* scr, int lane) {
#pragma unroll
    for (int i = 0; i < 8; ++i) { const int kk = i * 8 + (lane >> 3); const f32x4 v = *(const GAS f32x4*)(W + (size_t)(k0 + kk) * ldw + n0 + (lane & 7) * 4);
        LAS float* s = scr + kk * 33 + (lane & 7) * 4; s[0] = v[0]; s[1] = v[1]; s[2] = v[2]; s[3] = v[3]; }
    LDS_WAIT(); asm volatile("" ::: "memory");
    const int c = lane & 7;
#pragma unroll
    for (int j = 0; j < 4; ++j) { const int n = (lane >> 3) + 8 * j; const LAS float* s = scr + (8 * c) * 33 + n;
        u32x4 o; o.x = cvtpk(s[0 * 33], s[1 * 33]); o.y = cvtpk(s[2 * 33], s[3 * 33]); o.z = cvtpk(s[4 * 33], s[5 * 33]); o.w = cvtpk(s[6 * 33], s[7 * 33]);
        *(GAS u32x4*)(WT + (size_t)map_row<MODE>(n0 + n) * K + k0 + 8 * c) = o; }
    LDS_WAIT(); asm volatile("" ::: "memory");
}
template <int MODE> __device__ __forceinline__ void tr_mat8(const float* W, int K, int N, unsigned char* WT, LAS float* scr, int lane, int item) {
    const int nblk = N / 32, kb = item / nblk, nb = item % nblk, k0 = kb * 64, n0 = nb * 32;
#pragma unroll
    for (int i = 0; i < 8; ++i) { const int kk = i * 8 + (lane >> 3); const f32x4 v = *(const GAS f32x4*)(W + (size_t)(k0 + kk) * N + n0 + (lane & 7) * 4);
        LAS float* s = scr + kk * 33 + (lane & 7) * 4; s[0] = v[0]; s[1] = v[1]; s[2] = v[2]; s[3] = v[3]; }
    LDS_WAIT(); asm volatile("" ::: "memory");
    const int c = lane & 7;
#pragma unroll
    for (int j = 0; j < 4; ++j) { const int n = (lane >> 3) + 8 * j; const LAS float* s = scr + (8 * c) * 33 + n;
        u32x2 o; o.x = cvt4_fp8(s[0 * 33] * 64.f, s[1 * 33] * 64.f, s[2 * 33] * 64.f, s[3 * 33] * 64.f); o.y = cvt4_fp8(s[4 * 33] * 64.f, s[5 * 33] * 64.f, s[6 * 33] * 64.f, s[7 * 33] * 64.f);
        *(GAS u32x2*)(WT + (size_t)map_row<MODE>(n0 + n) * K + k0 + 8 * c) = o; }
    LDS_WAIT(); asm volatile("" ::: "memory");
}
template <int MODE> __device__ __forceinline__ void tr_mat(const float* W, int K, int N, bf16_t* WT, LAS float* scr, int lane, int item) {
    const int nblk = N / 32, kb = item / nblk, nb = item % nblk;
    tr_item<MODE>(W, N, K, kb * 64, nb * 32, WT, scr, lane);
}

__global__ void __launch_bounds__(512, 2) mega_fwd(Args args) {
    extern __shared__ __attribute__((aligned(16))) unsigned char lds_raw[];
    LAS unsigned char* lds = (LAS unsigned char*)lds_raw;
    volatile LAS unsigned* MISC = (volatile LAS unsigned*)(lds + MISC_OFF);
    const int tid = threadIdx.x, lane = tid & 63, wave = __builtin_amdgcn_readfirstlane(tid >> 6);
    const int G = gridDim.x, bx = blockIdx.x;
    unsigned char* ws = args.ws;
    unsigned* ctl = (unsigned*)(ws + WS_CTL);
    for (int u = tid; u < (LDS_BYTES - LDSCTL_OFF) / 4; u += 512) ((LAS unsigned*)(lds + LDSCTL_OFF))[u] = 0u;
    __syncthreads();
    XcdBarrier bar; bar.bar = ctl + CW_BAR; bar.x = 0; bar.st = nullptr;
    if (MK_N_LAUNCHES == 1) bar = xcd_barrier_post(ctl + CW_BAR, MISC + 8);
    const int lo = args.ph_lo, hi = args.ph_hi;
#ifndef PH_MASK
#define PH_MASK 0xFFFF
#endif
#define IN(k) (((PH_MASK >> (k)) & 1) && lo <= (k) && (k) < hi)
#ifndef REP_MASK
#define REP_MASK 0
#endif
#define REPS(k) (((REP_MASK >> (k)) & 1) ? 2 : 1)
#define SEAM(k) do { if (MK_N_LAUNCHES == 1 && IN(k) && IN((k) + 1)) xcd_barrier(bar); } while (0)
    const int gw = bx * 8 + wave, NGW = G * 8;

    const float* x = args.in[I_X];
    bf16_t* Z = (bf16_t*)(ws + WS_R1);
    bf16_t* QM = (bf16_t*)(ws + WS_QM); bf16_t* KV = (bf16_t*)(ws + WS_KV); bf16_t* KR = (bf16_t*)(ws + WS_KR);
    bf16_t* YA = (bf16_t*)(ws + WS_YA); bf16_t* YB = (bf16_t*)(ws + WS_YB); bf16_t* M1 = (bf16_t*)(ws + WS_M1); unsigned char* MG8 = ws + WS_R4;
    float* H1 = (float*)(ws + WS_H1); float* EB = (float*)(ws + WS_R4);
    unsigned char* XG = ws + WS_R1; unsigned char* HACT = ws + WS_R2; bf16_t* YY = (bf16_t*)(ws + WS_R1); unsigned char* XN8 = ws + WS_XN;
    bf16_t* PB = (bf16_t*)(ws + WS_PB);
    float* ROPE = (float*)(ws + WS_ROPE); float* KM = (float*)(ws + WS_KM);
    int* TILE = (int*)(ws + WS_TILE); int* AE = (int*)(ws + WS_AE); int* AP = (int*)(ws + WS_AP); float* AW = (float*)(ws + WS_AW); int* DEST = (int*)(ws + WS_DEST);
    unsigned char* WIN8 = ws + WS_WIN; bf16_t* WUQ = (bf16_t*)(ws + WS_WUQ); bf16_t* WUKV = (bf16_t*)(ws + WS_WUKV); bf16_t* WOA = (bf16_t*)(ws + WS_WOA); bf16_t* WOB = (bf16_t*)(ws + WS_WOB);
    unsigned char* WOUT8 = ws + WS_WOUT; unsigned char* WPG8 = ws + WS_WPG; bf16_t* WPLE = (bf16_t*)(ws + WS_WPLE); unsigned char* WGU = ws + WS_WGU; unsigned char* WDN = ws + WS_WDN;

    if (IN(0)) for (int rep_ = 0; rep_ < REPS(0); ++rep_) {
        LAS float* scr = (LAS float*)(lds + wave * 16384);
        constexpr int I0 = 32 * 258, I1 = 8 * 48, I2 = 8 * 64, I3 = 16 * 64, I4 = 16 * 64, I5 = 32 * 64, I6 = 32 * 64, I7 = 4 * 64, IE = 32 * 64;
        constexpr int NSMALL = I0 + I1 + I2 + I3 + I4 + I5 + I6 + I7, NITEMS = NSMALL + 3 * 32 * IE;
        for (int it = gw; it < NITEMS; it += NGW) {
            int r = it;
            if (r < I0) { tr_mat8<1>(args.in[I_W_IN], 2048, 8256, WIN8, scr, lane, r); continue; } r -= I0;
            if (r < I1) { tr_mat<2>(args.in[I_W_UQ], 512, 1536, WUQ, scr, lane, r); continue; } r -= I1;
            if (r < I2) { tr_mat<0>(args.in[I_W_UKV], 512, 2048, WUKV, scr, lane, r); continue; } r -= I2;
            if (r < I3) { tr_mat<0>(args.in[I_W_O_MLA], 1024, 2048, WOA, scr, lane, r); continue; } r -= I3;
            if (r < I4) { tr_mat<0>(args.in[I_W_O_MOBA], 1024, 2048, WOB, scr, lane, r); continue; } r -= I4;
            if (r < I5) { tr_mat8<0>(args.in[I_W_OUT], 2048, 2048, WOUT8, scr, lane, r); continue; } r -= I5;
            if (r < I6) { tr_mat8<0>(args.in[I_W_PLE_GATE], 2048, 2048, WPG8, scr, lane, r); continue; } r -= I6;
            if (r < I7) { tr_mat<0>(args.in[I_W_PLE], 256, 2048, WPLE, scr, lane, r); continue; } r -= I7;
            const int which = r / (32 * IE), rr = r % (32 * IE), e = rr / IE, item = rr % IE;
            if (which == 0) tr_mat8<3>(args.in[I_W_GATE] + (size_t)e * DM * DM, 2048, 2048, WGU + (size_t)e * 4096 * 2048, scr, lane, item);
            else if (which == 1) tr_mat8<4>(args.in[I_W_UP] + (size_t)e * DM * DM, 2048, 2048, WGU + (size_t)e * 4096 * 2048, scr, lane, item);
            else tr_mat8<0>(args.in[I_W_DOWN] + (size_t)e * DM * DM, 2048, 2048, WDN + (size_t)e * 2048 * 2048, scr, lane, item);
        }
        for (int i = bx * 512 + tid; i < 192 * 2048 / 16; i += G * 512) *(u32x4*)(WIN8 + (size_t)8256 * 2048 + (size_t)i * 16) = (u32x4){0u, 0u, 0u, 0u};
        { const float* gn = args.in[I_ATTN_NORM];
          for (int m = gw; m < T; m += NGW) { const f32x4* xr = (const f32x4*)(x + (size_t)m * DM) + lane; f32x4 v[8]; float s = 0.f;
#pragma unroll
              for (int j = 0; j < 8; ++j) { v[j] = xr[64 * j]; s += (v[j][0] * v[j][0] + v[j][1] * v[j][1]) + (v[j][2] * v[j][2] + v[j][3] * v[j][3]); }
              const float rstd = 1.0f / sqrtf(wave_sum(s) * (1.0f / DM) + EPS);
              unsigned* o4 = (unsigned*)(XN8 + (size_t)m * DM) + lane;
#pragma unroll
              for (int j = 0; j < 8; ++j) { const f32x4 gv = ((const f32x4*)gn)[64 * j + lane]; o4[64 * j] = cvt4_fp8(v[j][0] * rstd * gv[0], v[j][1] * rstd * gv[1], v[j][2] * rstd * gv[2], v[j][3] * rstd * gv[3]); } } }
        { const float* p = args.in[I_P];
          for (int i = bx * 512 + tid; i < T * 256 / 8; i += G * 512) { const f32x4 a = *(const f32x4*)(p + (size_t)i * 8), b = *(const f32x4*)(p + (size_t)i * 8 + 4); *(u32x4*)(PB + (size_t)i * 8) = pg8::pack8(a, b); } }
        for (int i = bx * 512 + tid; i < SEQ * 32; i += G * 512) { const int pos = i >> 5, j = i & 31; double rev = (double)pos * ROPE_REV[j]; rev -= floor(rev); const float fr = (float)rev;
            ROPE[2 * i] = __builtin_amdgcn_cosf(fr); ROPE[2 * i + 1] = __builtin_amdgcn_sinf(fr); }
    }
    SEAM(0);

    if (IN(1)) for (int rep_ = 0; rep_ < REPS(1); ++rep_) {
        pg8::Gemm g{DM, DM, DM, 0x7f7f7f7f, 0x79797979}; pg8::DenseOrder S; S.init(XN8, DM, WIN8, DM, T, NZ, G, bx);
        pg8::EpiStore E{Z, NZ};
        pg8::gemm_phase<pg8::EpiStore, pg8::DenseOrder, true>(lds, g, S, E);
    }
    SEAM(1);

    if (IN(2)) {
        const float* gq = args.in[I_QLN]; const float* gk = args.in[I_KVLN];
        for (int m = gw; m < T; m += NGW) { bf16_t* zr = Z + (size_t)m * NZ;
#pragma unroll
            for (int w2 = 0; w2 < 2; ++w2) { bf16_t* p = zr + (w2 ? ZC_KVL : ZC_QL) + lane * 8; const float* gp = (w2 ? gk : gq) + lane * 8;
                f32x4 a, b; pg8::unpack8(*(const u32x4*)p, a, b);
                const float s = (a[0] * a[0] + a[1] * a[1]) + (a[2] * a[2] + a[3] * a[3]) + (b[0] * b[0] + b[1] * b[1]) + (b[2] * b[2] + b[3] * b[3]);
                const float rstd = 1.0f / sqrtf(wave_sum(s) * (1.0f / 512.0f) + EPS);
                const f32x4 g0 = *(const f32x4*)gp, g1 = *(const f32x4*)(gp + 4);
                *(u32x4*)p = pg8::pack8(a * rstd * g0, b * rstd * g1); }
            if (lane < 32) { const int pos = m & (SEQ - 1); const float x1 = bf2f(zr[ZC_KR + lane]), x2 = bf2f(zr[ZC_KR + 32 + lane]); const float c = ROPE[(pos * 32 + lane) * 2], s = ROPE[(pos * 32 + lane) * 2 + 1];
                *(unsigned*)(KR + (size_t)m * 64 + 2 * lane) = cvtpk(x1 * c - x2 * s, x1 * s + x2 * c); } }
        { LAS float* part = (LAS float*)lds;
          for (int it = bx; it < NBATCH * 8 * 16; it += G) { const int b = it >> 7, hh = (it >> 4) & 7, blk = it & 15; const int c8 = tid & 15, rg = tid >> 4;
              const bf16_t* kp = Z + (size_t)(b * SEQ + blk * 256 + rg * 8) * NZ + ZC_KB + hh * 128 + c8 * 8;
              f32x4 s0 = {0.f, 0.f, 0.f, 0.f}, s1 = {0.f, 0.f, 0.f, 0.f};
#pragma unroll
              for (int r = 0; r < 8; ++r) { f32x4 a, bq; pg8::unpack8(*(const u32x4*)(kp + (size_t)r * NZ), a, bq); s0 += a; s1 += bq; }
              *(LAS f32x4*)(part + rg * 128 + c8 * 8) = s0; *(LAS f32x4*)(part + rg * 128 + c8 * 8 + 4) = s1;
              __syncthreads();
              if (tid < 128) { float s = 0.f;
#pragma unroll
                  for (int r = 0; r < 32; ++r) s += part[r * 128 + tid];
                  KM[(size_t)it * 128 + tid] = s * (1.0f / 256.0f); }
              __syncthreads(); } }
    }
    SEAM(2);

    if (IN(3)) {
        { pg8::Gemm g{NZ * 2, 1024, 1024, 0, 0}; pg8::DenseOrder S; S.init(Z + ZC_QL, NZ * 2, WUQ, 1024, T, 1536, G, bx);
          pg8::EpiQRope E{QM, 1536, (const f32x4*)ROPE};
          pg8::gemm_phase<pg8::EpiQRope, pg8::DenseOrder>(lds, g, S, E); }
        { pg8::Gemm g{NZ * 2, 1024, 1024, 0, 0}; pg8::DenseOrder S; S.init(Z + ZC_KVL, NZ * 2, WUKV, 1024, T, 2048, G, bx);
          pg8::EpiStore E{KV, 2048};
          pg8::gemm_phase<pg8::EpiStore, pg8::DenseOrder>(lds, g, S, E); }
    }
    SEAM(3);

    if (IN(4)) for (int rep_ = 0; rep_ < REPS(4); ++rep_) {
#ifndef NO_MLA
        for (int it = bx; it < 256; it += G) {
            const int xcd = it & 7, k = it >> 3, bh = xcd * 4 + (k >> 3), pr = k & 7, b = bh >> 3, hh = bh & 7;
#pragma unroll 1
            for (int pass = 0; pass < 2; ++pass) { const int qb = pass ? pr : 15 - pr;
                att::attn_unit<true>((char*)lds_raw, hh, qb, QM + (size_t)b * SEQ * 1536 + hh * 192, 1536, KV + (size_t)b * SEQ * 2048 + hh * 256, 2048, KR + (size_t)b * SEQ * 64,
                                     KV + (size_t)b * SEQ * 2048 + hh * 256 + 128, 2048, YA + (size_t)b * SEQ * 1024 + hh * 128, 1024, nullptr, nullptr); }
        }
#endif
#ifndef NO_MOBA
        for (int it = bx; it < 256; it += G) {
            const int xcd = it & 7, k = it >> 3, bh = xcd * 4 + (k >> 3), pr = k & 7, b = bh >> 3, hh = bh & 7;
            const bf16_t* zb = Z + (size_t)b * SEQ * NZ + hh * 128;
#pragma unroll 1
            for (int pass = 0; pass < 2; ++pass) { const int qb = pass ? pr : 15 - pr;
                att::attn_unit<false>((char*)lds_raw, hh, qb, zb + ZC_QB, NZ, zb + ZC_KB, NZ, nullptr, zb + ZC_VB, NZ, YB + (size_t)b * SEQ * 1024 + hh * 128, 1024,
                                      KM + (size_t)bh * 16 * 128, args.in[I_REL_BIAS]); }
        }
#endif
    }
    SEAM(4);

    if (IN(5)) {
        pg8::Gemm g{2048, 2048, 2048, 0, 0}; pg8::DenseOrder S; S.init(YA, 2048, WOA, 2048, T, DM, G, bx);
        pg8::EpiGate<false, false> E{Z + ZC_GA, NZ, nullptr, M1, DM};
        pg8::gemm_phase<pg8::EpiGate<false, false>, pg8::DenseOrder>(lds, g, S, E);
    }
    SEAM(5);
    if (IN(6)) {
        pg8::Gemm g{2048, 2048, 2048, 0, 0}; pg8::DenseOrder S; S.init(YB, 2048, WOB, 2048, T, DM, G, bx);
        pg8::EpiGate<true, true> E{Z + ZC_GB, NZ, M1, MG8, DM};
        pg8::gemm_phase<pg8::EpiGate<true, true>, pg8::DenseOrder>(lds, g, S, E);
    }
    SEAM(6);
    if (IN(7)) {
        pg8::Gemm g{DM, DM, DM, 0x7f7f7f7f, 0x79797979}; pg8::DenseOrder S; S.init(MG8, DM, WOUT8, DM, T, DM, G, bx);
        pg8::EpiResF32 E{x, H1, DM};
        pg8::gemm_phase<pg8::EpiResF32, pg8::DenseOrder, true>(lds, g, S, E);
    }
    SEAM(7);

    if (IN(8)) {
        LAS float* xs = (LAS float*)lds;
        LAS float* part = (LAS float*)(lds + 65536);
        LAS float* lg = (LAS float*)(lds + 65536 + 16384);
        const float* gn = args.in[I_MOE_NORM]; const float* wr_ = args.in[I_W_ROUTER]; const float* br = args.in[I_B_ROUTER];
        for (int ch = bx; ch < T / 8; ch += G) {
            const int m = ch * 8 + wave;
            { const f32x4* xr = (const f32x4*)(H1 + (size_t)m * DM) + lane; f32x4 v[8]; float s = 0.f;
#pragma unroll
              for (int j = 0; j < 8; ++j) { v[j] = xr[64 * j]; s += (v[j][0] * v[j][0] + v[j][1] * v[j][1]) + (v[j][2] * v[j][2] + v[j][3] * v[j][3]); }
              const float rstd = 1.0f / sqrtf(wave_sum(s) * (1.0f / DM) + EPS);
              unsigned* o4 = (unsigned*)(XN8 + (size_t)m * DM) + lane;
#pragma unroll
              for (int j = 0; j < 8; ++j) { const f32x4 gv = ((const f32x4*)gn)[64 * j + lane]; const f32x4 y = v[j] * rstd * gv;
                  o4[64 * j] = cvt4_fp8(y[0], y[1], y[2], y[3]); *(LAS f32x4*)(xs + wave * DM + (64 * j + lane) * 4) = y; } }
            __syncthreads();
            { const int e = tid & 31, ks = tid >> 5; float acc[8];
#pragma unroll
              for (int r = 0; r < 8; ++r) acc[r] = 0.f;
              for (int k4 = 0; k4 < 32; ++k4) { const int k = ks * 128 + k4 * 4;
                  const float w0 = wr_[(size_t)(k + 0) * 32 + e], w1 = wr_[(size_t)(k + 1) * 32 + e], w2 = wr_[(size_t)(k + 2) * 32 + e], w3 = wr_[(size_t)(k + 3) * 32 + e];
#pragma unroll
                  for (int r = 0; r < 8; ++r) { const f32x4 xv = *(const LAS f32x4*)(xs + r * DM + k); acc[r] += xv[0] * w0 + xv[1] * w1 + xv[2] * w2 + xv[3] * w3; } }
#pragma unroll
              for (int r = 0; r < 8; ++r) part[(ks * 8 + r) * 32 + e] = acc[r]; }
            __syncthreads();
            if (tid < 256) { const int r = tid >> 5, e = tid & 31; float s = br[e];
#pragma unroll
                for (int ks = 0; ks < 16; ++ks) s += part[(ks * 8 + r) * 32 + e];
                lg[r * 32 + e] = s; }
            __syncthreads();
            if (tid < 8) { const int tok = ch * 8 + tid; float v0 = -__builtin_inff(), v1 = v0, v2 = v0, v3 = v0; int i0 = 0, i1 = 0, i2 = 0, i3 = 0;
                for (int e = 0; e < 32; ++e) { const float xv = lg[tid * 32 + e];
                    if (xv > v0) { v3 = v2; i3 = i2; v2 = v1; i2 = i1; v1 = v0; i1 = i0; v0 = xv; i0 = e; }
                    else if (xv > v1) { v3 = v2; i3 = i2; v2 = v1; i2 = i1; v1 = xv; i1 = e; }
                    else if (xv > v2) { v3 = v2; i3 = i2; v2 = xv; i2 = e; }
                    else if (xv > v3) { v3 = xv; i3 = e; } }
                const float e1 = __expf(v1 - v0), e2 = __expf(v2 - v0), e3 = __expf(v3 - v0), inv = 1.0f / (1.0f + e1 + e2 + e3);
                const int p0 = (int)atomicAdd(ctl + CW_CNT + 64 * i0, 1u), p1 = (int)atomicAdd(ctl + CW_CNT + 64 * i1, 1u), p2 = (int)atomicAdd(ctl + CW_CNT + 64 * i2, 1u), p3 = (int)atomicAdd(ctl + CW_CNT + 64 * i3, 1u);
                *(int4*)(AE + tok * 4) = make_int4(i0, i1, i2, i3); *(int4*)(AP + tok * 4) = make_int4(p0, p1, p2, p3); *(f32x4*)(AW + tok * 4) = (f32x4){inv, e1 * inv, e2 * inv, e3 * inv}; }
            __syncthreads();
        }
    }
    SEAM(8);

    if (IN(9)) {
        LAS int* pst = (LAS int*)lds;
        if (tid == 0) { int run = 0;
            for (int e = 0; e < NE; ++e) { const int c = (int)__hip_atomic_load(ctl + CW_CNT + 64 * e, RLX_AGENT); pst[e] = run; pst[32 + e] = c; run += (c + 255) & ~255; }
            pst[64] = run >> 8; }
        __syncthreads();
        if (bx == 0) { if (tid == 0) TILE[0] = pst[64];
            if (tid < NE) { const int s = pst[tid] >> 8, n = (pst[32 + tid] + 255) >> 8; for (int i = 0; i < n; ++i) TILE[16 + s + i] = tid; } }
        for (int a = gw; a < NA; a += NGW) { const int tok = a >> 2; const int e = AE[a], dest = pst[e] + AP[a];
            if (lane == 0) DEST[a] = dest;
            const u32x4* src = (const u32x4*)(XN8 + (size_t)tok * DM) + lane; u32x4* dst = (u32x4*)(XG + (size_t)dest * DM) + lane;
#pragma unroll
            for (int j = 0; j < 2; ++j) dst[64 * j] = src[64 * j]; }
        for (int e = 0; e < NE; ++e) { const int r0 = pst[e] + pst[32 + e], r1 = pst[e] + ((pst[32 + e] + 255) & ~255);
            for (int r = r0 + gw; r < r1; r += NGW) { u32x4* dst = (u32x4*)(XG + (size_t)r * DM) + lane;
#pragma unroll
                for (int j = 0; j < 2; ++j) dst[64 * j] = (u32x4){0u, 0u, 0u, 0u}; } }
        __syncthreads();
    }
    SEAM(9);

    if (IN(10)) for (int rep_ = 0; rep_ < REPS(10); ++rep_) {
        pg8::Gemm g{DM, DM, DM, 0x7f7f7f7f, 0x79797979}; pg8::GroupedOrder S; S.tile_e = TILE + 16; S.ntiles = __builtin_amdgcn_readfirstlane(ld_agent_i(TILE)); S.nN = 16; S.G = G; S.c = bx;
        S.A = (const char*)XG; S.B = (const char*)WGU; S.atile = (size_t)256 * DM; S.btile = (size_t)256 * DM; S.bexp = (size_t)4096 * DM;
        pg8::EpiSwiglu E{args.in[I_B_GATE], args.in[I_B_UP], HACT};
        pg8::gemm_phase<pg8::EpiSwiglu, pg8::GroupedOrder, true>(lds, g, S, E);
    }
    SEAM(10);
    if (IN(11)) {
        pg8::Gemm g{DM, DM, DM, 0x7f7f7f7f, 0x79797979}; pg8::GroupedOrder S; S.tile_e = TILE + 16; S.ntiles = __builtin_amdgcn_readfirstlane(ld_agent_i(TILE)); S.nN = 8; S.G = G; S.c = bx;
        S.A = (const char*)HACT; S.B = (const char*)WDN; S.atile = (size_t)256 * DM; S.btile = (size_t)256 * DM; S.bexp = (size_t)2048 * DM;
        pg8::EpiDown E{args.in[I_B_DOWN], YY};
        pg8::gemm_phase<pg8::EpiDown, pg8::GroupedOrder, true>(lds, g, S, E);
    }
    SEAM(11);

    if (IN(12)) {
        const float* gn = args.in[I_PLE_NORM]; int ln = lane; asm volatile("" : "+v"(ln));
        for (int m = gw; m < T; m += NGW) { f32x4* hr = (f32x4*)(H1 + (size_t)m * DM) + ln; f32x4 v[8];
#pragma unroll
            for (int j = 0; j < 8; ++j) v[j] = hr[64 * j];
#pragma unroll
            for (int k = 0; k < 4; ++k) { const int dest = DEST[m * 4 + k]; const float w = AW[m * 4 + k]; const u32x2* yr = (const u32x2*)(YY + (size_t)dest * DM) + ln;
#pragma unroll
                for (int j = 0; j < 8; ++j) { const u32x2 y = yr[64 * j]; v[j][0] += w * bflo(y.x); v[j][1] += w * bfhi(y.x); v[j][2] += w * bflo(y.y); v[j][3] += w * bfhi(y.y); } }
            float s = 0.f;
#pragma unroll
            for (int j = 0; j < 8; ++j) { hr[64 * j] = v[j]; s += (v[j][0] * v[j][0] + v[j][1] * v[j][1]) + (v[j][2] * v[j][2] + v[j][3] * v[j][3]); }
            const float rstd = 1.0f / sqrtf(wave_sum(s) * (1.0f / DM) + EPS);
            unsigned* o4 = (unsigned*)(XN8 + (size_t)m * DM) + ln;
#pragma unroll
            for (int j = 0; j < 8; ++j) { const f32x4 gv = ((const f32x4*)gn)[64 * j + ln]; o4[64 * j] = cvt4_fp8(v[j][0] * rstd * gv[0], v[j][1] * rstd * gv[1], v[j][2] * rstd * gv[2], v[j][3] * rstd * gv[3]); } }
    }
    SEAM(12);

    if (IN(13)) {
        pg8::Gemm g{512, 512, 512, 0, 0}; pg8::DenseOrder S; S.init(PB, 512, WPLE, 512, T, DM, G, bx);
        pg8::EpiResF32 E{nullptr, EB, DM};
        pg8::gemm_phase<pg8::EpiResF32, pg8::DenseOrder>(lds, g, S, E);
    }
    SEAM(13);
    if (IN(14)) {
        pg8::Gemm g{DM, DM, DM, 0x7f7f7f7f, 0x79797979}; pg8::DenseOrder S; S.init(XN8, DM, WPG8, DM, T, DM, G, bx);
        pg8::EpiPle E{H1, EB, args.out};
        pg8::gemm_phase<pg8::EpiPle, pg8::DenseOrder, true>(lds, g, S, E);
    }
    SEAM(14);
    if (IN(15)) {
        const float* gn = args.in[I_FINAL_NORM]; int ln = lane; asm volatile("" : "+v"(ln));
        for (int m = gw; m < T; m += NGW) { f32x4* xr = (f32x4*)(args.out + (size_t)m * DM) + ln; f32x4 v[8]; float s = 0.f;
#pragma unroll
            for (int j = 0; j < 8; ++j) { v[j] = xr[64 * j]; s += (v[j][0] * v[j][0] + v[j][1] * v[j][1]) + (v[j][2] * v[j][2] + v[j][3] * v[j][3]); }
            const float rstd = 1.0f / sqrtf(wave_sum(s) * (1.0f / DM) + EPS);
#pragma unroll
            for (int j = 0; j < 8; ++j) { const f32x4 gv = ((const f32x4*)gn)[64 * j + ln]; xr[64 * j] = v[j] * rstd * gv; } }
    }
#undef IN
#undef SEAM
}

extern "C" void kernel_launch(void* const* d_in, const int* in_sizes, int n_in, void* d_out, int out_size, void* d_ws, size_t ws_size, hipStream_t stream) {
    static int grid = 0;
    if (grid == 0) {
        if (n_in != 25 || out_size != T * DM || ws_size < WS_END) { fprintf(stderr, "kernel_launch: unexpected shapes (n_in %d, out %d, ws %zu < %zu)\n", n_in, out_size, ws_size, (size_t)WS_END); grid = -1; return; }
        int dev = 0, cus = 0, per_cu = 0;
        if (hipGetDevice(&dev) != hipSuccess || hipDeviceGetAttribute(&cus, hipDeviceAttributeMultiprocessorCount, dev) != hipSuccess) { grid = -1; return; }
        if (hipFuncSetAttribute((const void*)mega_fwd, hipFuncAttributeMaxDynamicSharedMemorySize, LDS_BYTES) != hipSuccess) { fprintf(stderr, "kernel_launch: hipFuncSetAttribute failed\n"); grid = -1; return; }
        if (hipOccupancyMaxActiveBlocksPerMultiprocessor(&per_cu, (const void*)mega_fwd, 512, LDS_BYTES) != hipSuccess || per_cu < 1) { fprintf(stderr, "kernel_launch: occupancy query says %d blocks per CU\n", per_cu); }
        (void)hipGetLastError();
        grid = cus;
    }
    if (grid < 0) return;
    (void)in_sizes;
    if (hipMemsetAsync((char*)d_ws + WS_CTL, 0, CTL_ZERO_BYTES, stream) != hipSuccess) return;
    Args a{};
    for (int i = 0; i < 25; ++i) a.in[i] = (const float*)d_in[i];
    a.out = (float*)d_out; a.ws = (unsigned char*)d_ws;
    for (int li = 0; li < MK_N_LAUNCHES; ++li) {
        a.ph_lo = (MK_N_LAUNCHES == 1) ? 0 : li; a.ph_hi = (MK_N_LAUNCHES == 1) ? NPHASE : li + 1;
        hipLaunchKernelGGL(mega_fwd, dim3(grid), dim3(512), LDS_BYTES, stream, a);
    }
}
```
